# Optimizing an MI355X kernel written in HIP

```python
import math
import jax, jax.numpy as jnp
from jax import lax
import numpy as np

D_MODEL = 1024
BATCH = 4
SEQ = 8192
DEPTH = 2

GRID_W = 64
CTX_LEN = 256

CONV_DIM = 512
CONV_WIDTH = 3
GLA_HEADS = 4
GLA_DK = 64
GLA_DV = 128
GLA_KEY = GLA_HEADS * GLA_DK
GLA_VAL = GLA_HEADS * GLA_DV
GLA_LOWRANK = 16
GLA_GATE_TEMP = 16.0
GLA_CHUNK = 64
GLA_COL_HEADS = 2
MIX_DIM = CONV_DIM + GLA_VAL

STATE_SIZES = (GLA_KEY, GLA_VAL, GLA_LOWRANK, GLA_LOWRANK)
STATE_COLS = GLA_KEY + GLA_VAL + 2 * GLA_LOWRANK
REST_SIZES = (GLA_KEY, GLA_VAL, 3 * CONV_DIM)
IN_COLS = STATE_COLS + GLA_KEY + GLA_VAL + 3 * CONV_DIM

N_EXPERTS = 256
TOP_K = 8
N_GROUPS = 8
TOPK_GROUPS = 4
EXPERT_HIDDEN = 256
SHARED_HIDDEN = 256
ROUTED_SCALE = 2.5
MOE_BLOCK = 128

DEEPNORM_ALPHA = (2 * DEPTH) ** 0.25
DEEPNORM_BETA = (8 * DEPTH) ** -0.25
LN_EPS = 1e-5
RMS_EPS = 1e-6

kernel_name = "hybrid_conv_gla_moe_dit"


def layer_norm(x, g, b):
    xf = x.astype(jnp.float32)
    mu = jnp.mean(xf, -1, keepdims=True)
    var = jnp.mean(jnp.square(xf - mu), -1, keepdims=True)
    return ((xf - mu) * lax.rsqrt(var + LN_EPS) * g.astype(jnp.float32) + b.astype(jnp.float32)).astype(x.dtype)


def adaln(cond, w_mod, b_mod):
    m = jax.nn.silu(cond) @ w_mod + b_mod
    return jnp.split(m, 6, axis=-1)


def modulate(h, shift, scale):
    return h * (1.0 + scale[:, None, :]) + shift[:, None, :]


def split_sizes(p, sizes):
    cuts = [int(s) for s in np.cumsum(sizes)[:-1]]
    return jnp.split(p, cuts, axis=-1)


def to_heads(a, dh):
    b, l, _ = a.shape
    return a.reshape(b, l, -1, dh).transpose(0, 2, 1, 3)


def flip(a):
    return jnp.flip(a, axis=2)


def grid_transpose(a, rows, cols):
    b, h, _, f = a.shape
    return a.reshape(b, h, rows, cols, f).swapaxes(2, 3).reshape(b, h, rows * cols, f)


def to_scan_order(a, rows):
    nr = GLA_HEADS - GLA_COL_HEADS
    return jnp.concatenate([a[:, :nr], grid_transpose(a[:, nr:], rows, GRID_W)], axis=1)


def from_scan_order(a, rows):
    nr = GLA_HEADS - GLA_COL_HEADS
    return jnp.concatenate([a[:, :nr], grid_transpose(a[:, nr:], GRID_W, rows)], axis=1)


def short_conv_mix(p_conv, w_conv, seg_len):
    bsz, l, _ = p_conv.shape
    b_gate, c_gate, v = jnp.split(p_conv, 3, axis=-1)
    u = (c_gate * v).reshape(bsz * (l // seg_len), seg_len, CONV_DIM)
    y = lax.conv_general_dilated(
        u, w_conv[:, None, :].astype(u.dtype), window_strides=(1,),
        padding=[(CONV_WIDTH // 2, CONV_WIDTH // 2)],
        dimension_numbers=("NWC", "WIO", "NWC"), feature_group_count=CONV_DIM)
    return b_gate * y.reshape(bsz, l, CONV_DIM)


def gla_state_inputs(p_state, w_decay_up, b_decay):
    pk, pv, paf, pab = split_sizes(p_state, STATE_SIZES)

    def log_decay(pa, d):
        z = (pa @ w_decay_up[d] + b_decay[d]).astype(jnp.float32)
        return to_heads(jax.nn.log_sigmoid(z) / GLA_GATE_TEMP, GLA_DK)

    return to_heads(pk, GLA_DK), to_heads(pv, GLA_DV), log_decay(paf, 0), log_decay(pab, 1)


def _chunked(a):
    b, h, t, f = a.shape
    return a.astype(jnp.float32).reshape(b, h, t // GLA_CHUNK, GLA_CHUNK, f)


def gla_states(k, v, log_a, s0):
    kc, vc = _chunked(k), _chunked(v)
    bcum = jnp.cumsum(_chunked(log_a), axis=3)
    b_last = bcum[:, :, :, -1, :]
    k_tail = kc * jnp.exp(b_last[:, :, :, None, :] - bcum)
    chunk_kv = jnp.einsum("bhnjk,bhnjv->bhnkv", k_tail, vc)

    def step(s, inp):
        dec, kv = inp
        return jnp.exp(dec)[..., None] * s + kv, s

    s_final, s_in = lax.scan(step, s0, (jnp.moveaxis(b_last, 2, 0), jnp.moveaxis(chunk_kv, 2, 0)))
    return bcum, jnp.moveaxis(s_in, 0, 2), s_final


def gla_scan(q, k, v, log_a, s0):
    bsz, h, t, _ = q.shape
    bcum, s_in, s_final = gla_states(k, v, log_a, s0)
    qc, kc, vc = _chunked(q), _chunked(k), _chunked(v)
    q_dec = qc * jnp.exp(bcum)
    att = jnp.einsum("bhnik,bhnjk->bhnij", q_dec, kc * jnp.exp(-bcum))
    incl = jnp.tril(jnp.ones((GLA_CHUNK, GLA_CHUNK), dtype=bool))
    att = jnp.where(incl, att, 0.0)
    o = jnp.einsum("bhnij,bhnjv->bhniv", att, vc) + jnp.einsum("bhnik,bhnkv->bhniv", q_dec, s_in)
    return o.reshape(bsz, h, t, GLA_DV), s_final


def gla_bidir(q, k, v, la_f, la_b, s0_f, s0_b):
    o_f, s_f = gla_scan(q, k, v, la_f, s0_f)
    o_b, s_b = gla_scan(flip(q), flip(k), flip(v), flip(la_b), s0_b)
    return o_f + flip(o_b), s_f, s_b


def gla_readout(o, gate, g_norm):
    b, h, l, dv = o.shape
    o = o * lax.rsqrt(jnp.mean(jnp.square(o), -1, keepdims=True) + RMS_EPS) * g_norm.astype(jnp.float32)
    o = o.transpose(0, 2, 1, 3).reshape(b, l, h * dv)
    return (o * jax.nn.silu(gate.astype(jnp.float32))).astype(gate.dtype)


def swiglu(u, w_gate, w_up, w_down):
    return (jax.nn.silu(u @ w_gate) * (u @ w_up)) @ w_down


def route(u, w_router, router_bias):
    n = u.shape[0]
    s = jax.nn.sigmoid((u @ w_router).astype(jnp.float32))
    biased = s + router_bias.astype(jnp.float32)
    grp = biased.reshape(n, N_GROUPS, N_EXPERTS // N_GROUPS)
    grp_score = jnp.sum(lax.top_k(grp, 2)[0], axis=-1)
    _, top_g = lax.top_k(grp_score, TOPK_GROUPS)
    gmask = jnp.any(top_g[..., None] == jnp.arange(N_GROUPS), axis=1)
    emask = jnp.repeat(gmask, N_EXPERTS // N_GROUPS, axis=-1)
    _, idx = lax.top_k(jnp.where(emask, biased, -jnp.inf), TOP_K)
    w = jnp.take_along_axis(s, idx, axis=-1)
    w = w / jnp.sum(w, -1, keepdims=True) * ROUTED_SCALE
    return idx, w


def routed_experts(u, idx, wts, w_gate, w_up, w_down):
    n, _ = u.shape
    nk = n * TOP_K
    flat_e = idx.reshape(nk)
    flat_w = wts.reshape(nk)
    flat_t = jnp.arange(nk, dtype=jnp.int32) // TOP_K
    order = jnp.argsort(flat_e)
    se, st, sw = flat_e[order], flat_t[order], flat_w[order]
    counts = jnp.bincount(flat_e, length=N_EXPERTS)
    start = jnp.cumsum(counts) - counts
    padded = (counts + MOE_BLOCK - 1) // MOE_BLOCK * MOE_BLOCK
    pend = jnp.cumsum(padded)
    pstart = pend - padded
    slot = pstart[se] + (jnp.arange(nk, dtype=jnp.int32) - start[se])
    n_blocks = -(-(nk + N_EXPERTS * (MOE_BLOCK - 1)) // MOE_BLOCK)
    n_slots = n_blocks * MOE_BLOCK
    slot_tok = jnp.zeros((n_slots,), jnp.int32).at[slot].set(st)
    slot_w = jnp.zeros((n_slots,), jnp.float32).at[slot].set(sw)
    block_start = jnp.arange(n_blocks, dtype=jnp.int32) * MOE_BLOCK
    block_e = jnp.minimum(jnp.searchsorted(pend, block_start, side="right"), N_EXPERTS - 1)
    total = pend[-1]

    def body(acc, blk):
        e, toks, ws, b0 = blk

        def add(a):
            xb = u[toks]
            yb = swiglu(xb, w_gate[e], w_up[e], w_down[e]) * ws[:, None].astype(u.dtype)
            return a.at[toks].add(yb.astype(a.dtype))

        return lax.cond(b0 < total, add, lambda a: a, acc), None

    out, _ = lax.scan(body, jnp.zeros_like(u),
                      (block_e, slot_tok.reshape(n_blocks, MOE_BLOCK), slot_w.reshape(n_blocks, MOE_BLOCK), block_start))
    return out


def moe_ffn(u, w_router, router_bias, w_e_gate, w_e_up, w_e_down, w_s_gate, w_s_up, w_s_down):
    idx, wts = route(u, w_router, router_bias)
    return swiglu(u, w_s_gate, w_s_up, w_s_down) + routed_experts(u, idx, wts, w_e_gate, w_e_up, w_e_down)


def setup_inputs(seed: int = 0) -> dict:
    key = jax.random.key(seed)
    ks = iter(jax.random.split(key, 32))
    d = D_MODEL

    def nrm(shape, scale):
        return jax.random.normal(next(ks), shape, jnp.float32) * scale

    return {
        "x": nrm((BATCH, SEQ, d), 1.0),
        "c": nrm((BATCH, d), 1.0),
        "ctx": nrm((BATCH, CTX_LEN, d), 1.0),
        "c_ctx": nrm((d,), 1.0),
        "w_mod": nrm((DEPTH, d, 6 * d), 0.5 * d ** -0.5),
        "b_mod": nrm((DEPTH, 6 * d), 0.02),
        "w_in": nrm((DEPTH, d, IN_COLS), d ** -0.5),
        "w_conv": nrm((DEPTH, CONV_WIDTH, CONV_DIM), CONV_WIDTH ** -0.5),
        "w_decay_up": nrm((DEPTH, 2, GLA_LOWRANK, GLA_KEY), GLA_LOWRANK ** -0.5),
        "b_decay": nrm((DEPTH, 2, GLA_KEY), 0.5),
        "g_gla_norm": 1.0 + nrm((DEPTH, GLA_DV), 0.02),
        "w_out": nrm((DEPTH, MIX_DIM, d), DEEPNORM_BETA * MIX_DIM ** -0.5),
        "ln1_g": 1.0 + nrm((DEPTH, d), 0.02),
        "ln1_b": nrm((DEPTH, d), 0.02),
        "w_router": nrm((DEPTH, d, N_EXPERTS), d ** -0.5),
        "router_bias": nrm((DEPTH, N_EXPERTS), 0.01),
        "w_e_gate": nrm((DEPTH, N_EXPERTS, d, EXPERT_HIDDEN), d ** -0.5),
        "w_e_up": nrm((DEPTH, N_EXPERTS, d, EXPERT_HIDDEN), d ** -0.5),
        "w_e_down": nrm((DEPTH, N_EXPERTS, EXPERT_HIDDEN, d), DEEPNORM_BETA * EXPERT_HIDDEN ** -0.5),
        "w_s_gate": nrm((DEPTH, d, SHARED_HIDDEN), d ** -0.5),
        "w_s_up": nrm((DEPTH, d, SHARED_HIDDEN), d ** -0.5),
        "w_s_down": nrm((DEPTH, SHARED_HIDDEN, d), DEEPNORM_BETA * SHARED_HIDDEN ** -0.5),
        "ln2_g": 1.0 + nrm((DEPTH, d), 0.02),
        "ln2_b": nrm((DEPTH, d), 0.02),
    }


def reference(x, c, ctx, c_ctx, w_mod, b_mod, w_in, w_conv, w_decay_up, b_decay, g_gla_norm, w_out,
              ln1_g, ln1_b, w_router, router_bias, w_e_gate, w_e_up, w_e_down, w_s_gate, w_s_up, w_s_down,
              ln2_g, ln2_b):
    bsz, seq, d = x.shape
    rows = seq // GRID_W
    ctx_len = ctx.shape[1]
    q_scale = GLA_DK ** -0.5
    zero_state = jnp.zeros((bsz, GLA_HEADS, GLA_DK, GLA_DV), jnp.float32)

    for i in range(DEPTH):
        last = i == DEPTH - 1
        sh1, sc1, gt1, sh2, sc2, gt2 = adaln(c, w_mod[i], b_mod[i])
        sh1c, sc1c, gt1c, sh2c, sc2c, gt2c = adaln(c_ctx[None, :], w_mod[i], b_mod[i])

        hc = modulate(ctx, sh1c, sc1c)
        pc = hc @ (w_in[i][:, :STATE_COLS] if last else w_in[i])
        kc, vc, lafc, labc = gla_state_inputs(pc[..., :STATE_COLS], w_decay_up[i], b_decay[i])
        if last:
            _, _, s_ctx_f = gla_states(kc, vc, lafc, zero_state)
            _, _, s_ctx_b = gla_states(flip(kc), flip(vc), flip(labc), zero_state)
        else:
            qc, gc, conv_in_c = split_sizes(pc[..., STATE_COLS:], REST_SIZES)
            qc = to_heads(qc, GLA_DK) * q_scale
            oc, s_ctx_f, s_ctx_b = gla_bidir(qc, kc, vc, lafc, labc, zero_state, zero_state)
            mix_c = jnp.concatenate([short_conv_mix(conv_in_c, w_conv[i], ctx_len),
                                     gla_readout(oc, gc, g_gla_norm[i])], axis=-1)
            ctx_mixed = layer_norm(DEEPNORM_ALPHA * ctx + gt1c[:, None, :] * (mix_c @ w_out[i]), ln1_g[i], ln1_b[i])

        hx = modulate(x, sh1, sc1)
        px = hx @ w_in[i]
        kx, vx, lafx, labx = gla_state_inputs(px[..., :STATE_COLS], w_decay_up[i], b_decay[i])
        qx, gx, conv_in_x = split_sizes(px[..., STATE_COLS:], REST_SIZES)
        qx = to_heads(qx, GLA_DK) * q_scale
        qx, kx, vx, lafx, labx = [to_scan_order(a, rows) for a in (qx, kx, vx, lafx, labx)]
        ox, _, _ = gla_bidir(qx, kx, vx, lafx, labx, s_ctx_f, s_ctx_b)
        ox = from_scan_order(ox, rows)
        mix_x = jnp.concatenate([short_conv_mix(conv_in_x, w_conv[i], GRID_W),
                                 gla_readout(ox, gx, g_gla_norm[i])], axis=-1)
        x = layer_norm(DEEPNORM_ALPHA * x + gt1[:, None, :] * (mix_x @ w_out[i]), ln1_g[i], ln1_b[i])

        hx2 = modulate(x, sh2, sc2).reshape(-1, d)
        moe_w = (w_router[i], router_bias[i], w_e_gate[i], w_e_up[i], w_e_down[i], w_s_gate[i], w_s_up[i], w_s_down[i])
        if last:
            fx = moe_ffn(hx2, *moe_w)
        else:
            ctx = ctx_mixed
            hc2 = modulate(ctx, sh2c, sc2c).reshape(-1, d)
            nc = hc2.shape[0]
            f = moe_ffn(jnp.concatenate([hc2, hx2], axis=0), *moe_w)
            ctx = layer_norm(DEEPNORM_ALPHA * ctx + gt2c[:, None, :] * f[:nc].reshape(ctx.shape), ln2_g[i], ln2_b[i])
            fx = f[nc:]
        x = layer_norm(DEEPNORM_ALPHA * x + gt2[:, None, :] * fx.reshape(x.shape), ln2_g[i], ln2_b[i])

    return x
```

```cpp
#include <hip/hip_runtime.h>
#include <cstdio>
#include <cstdint>

#ifndef REPMASK
#define REPMASK 0
#endif
#ifndef MK_N_LAUNCHES
#define MK_N_LAUNCHES 1
#endif

#define LAS __attribute__((address_space(3)))
#define GAS __attribute__((address_space(1)))
typedef unsigned short bf16_t;
typedef short bf16x8 __attribute__((ext_vector_type(8)));
typedef float f32x4 __attribute__((ext_vector_type(4)));
typedef float f32x2 __attribute__((ext_vector_type(2)));
typedef unsigned u32x4 __attribute__((ext_vector_type(4)));
typedef unsigned u32x2 __attribute__((ext_vector_type(2)));
typedef int i32x4 __attribute__((ext_vector_type(4)));

constexpr int D = 1024, NB = 4, SEQ = 8192, CTXL = 256, DEPTH = 2;
constexpr int NCTX = NB * CTXL;
constexpr int NLAT = NB * SEQ;
constexpr int NTOK = NCTX + NLAT;
constexpr int INC = 3104, INCP = 3328;
constexpr int C_K = 0, C_V = 256, C_DF = 768, C_DB = 784, C_Q = 800, C_G = 1056, C_CB = 1568, C_CC = 2080, C_CV = 2592;
constexpr int NEXP = 256, TOPK = 8, EH = 256;
constexpr int NCHUNK = 132;
constexpr int NCHAIN = 32;
constexpr int SH_BASE = 335872;
constexpr int NSLOT = SH_BASE + NTOK;
constexpr float ALPHA = 1.41421356237f;
constexpr float LN_EPS = 1e-5f, RMS_EPS = 1e-6f;

constexpr size_t al256(size_t x) { return (x + 255) & ~size_t(255); }
constexpr size_t WS_CTL = 0;
constexpr size_t WS_MOD = 65536;
constexpr size_t WS_WIN = WS_MOD + al256((size_t)2 * 5 * 6144 * 4);
constexpr size_t WS_WOUT = WS_WIN + (size_t)INCP * 1024 * 2;
constexpr size_t WS_WR = WS_WOUT + (size_t)1024 * 1024 * 2;
constexpr size_t WS_BT1 = WS_WR + (size_t)256 * 1024 * 2;
constexpr size_t WS_BT2 = WS_BT1 + (size_t)257 * 512 * 1024 * 2;
constexpr size_t WS_HX = WS_BT2 + (size_t)257 * 1024 * 256 * 2;
constexpr size_t WS_X1 = WS_HX + (size_t)NTOK * 1024 * 2;
constexpr size_t WS_XS = WS_X1 + (size_t)NTOK * 1024 * 4;
constexpr size_t WS_HX2 = WS_XS + (size_t)NTOK * 1024 * 4;
constexpr size_t WS_HX2Q = WS_HX2 + (size_t)NTOK * 1024 * 2;
constexpr size_t WS_LOG = WS_HX2Q + (size_t)NTOK * 1024;
constexpr size_t WS_IDX = WS_LOG + (size_t)NTOK * 256 * 4;
constexpr size_t WS_WTS = WS_IDX + (size_t)NTOK * 8 * 4;
constexpr size_t WS_POS = WS_WTS + (size_t)NTOK * 8 * 4;
constexpr size_t WS_HIST = WS_POS + (size_t)NTOK * 8 * 4;
constexpr size_t WS_STOK = WS_HIST + 262144;
constexpr size_t WS_MT = WS_STOK + (size_t)SH_BASE * 4;
constexpr size_t WS_H = WS_MT + 1536 * 16 + 256;
constexpr size_t WS_ARENA = WS_H + (size_t)NSLOT * 256 * 2;
constexpr size_t WS_PX = WS_ARENA;
constexpr size_t WS_KV = WS_PX + (size_t)NTOK * INCP * 2;
constexpr size_t WS_SS = WS_KV + (size_t)NCHAIN * NCHUNK * 128 * 64 * 2;
constexpr size_t WS_BL = WS_SS + (size_t)NCHAIN * NCHUNK * 128 * 64 * 2;
constexpr size_t WS_MIX = WS_BL + al256((size_t)NCHAIN * NCHUNK * 64 * 4);
constexpr size_t WS_YBF = WS_MIX + (size_t)NTOK * 1024 * 2;
constexpr size_t WS_LA = WS_YBF + (size_t)NTOK * 1024 * 2;
constexpr size_t WS_MIXEND = WS_LA + (size_t)NB * 4 * NCHUNK * 2 * 64 * 64 * 2;
constexpr size_t WS_Y = WS_ARENA;
constexpr size_t WS_END = WS_ARENA + (size_t)NSLOT * 1024 * 2;
static_assert(WS_MIXEND <= WS_END, "arena");

constexpr int LDS_BYTES = 147456;
constexpr int L_UTAB = 131072;
constexpr int L_NMY = 131072 + 448;
constexpr int L_ROWTAB = 131584;
constexpr int L_BAR = LDS_BYTES - 16;
constexpr int L_PTR = LDS_BYTES - 16 - 256;

#define XB_TMO      128
#define XB_XCNT(j)  (256  + 64 * (j))
#define XB_XSUB(j)  (1280 + 64 * (j))
#define XB_XGEN(j)  (2304 + 64 * (j))
#define XB_TOP      3328
#define XB_TOPGEN   3392
#define XCD_BAR_WORDS 3456
#define XB_SPIN_CAP (1u << 18)

__device__ __forceinline__ unsigned xb_ld(unsigned* p)              { return __hip_atomic_load(p, __ATOMIC_RELAXED, __HIP_MEMORY_SCOPE_AGENT); }
__device__ __forceinline__ unsigned xb_add(unsigned* p, unsigned v) { return __hip_atomic_fetch_add(p, v, __ATOMIC_RELAXED, __HIP_MEMORY_SCOPE_AGENT); }
__device__ __forceinline__ unsigned xb_xcc_id() { return (unsigned)__builtin_amdgcn_s_getreg((3 << 11) | 20) & 0xFu; }
#define XB_SPIN(cond, bar) do { unsigned _sp = 0; while (cond) { __builtin_amdgcn_s_sleep(1); \
    if ((++_sp & 255u) == 0u) { if (xb_ld(&(bar)[XB_TMO])) break; if (_sp > XB_SPIN_CAP) { atomicAdd(&(bar)[XB_TMO], 1u); break; } } } } while (0)

struct XcdBarrier { unsigned* bar; unsigned x; volatile LAS unsigned* st; };

__device__ __forceinline__ XcdBarrier xcd_barrier_post(unsigned* bar, volatile LAS unsigned* st) {
    XcdBarrier b; b.bar = bar; b.x = xb_xcc_id(); b.st = st;
    if (threadIdx.x == 0) (void)xb_add(&bar[XB_XCNT(b.x)], 1u);
    return b;
}
__device__ __forceinline__ void xcd_barrier_complete(unsigned* bar, unsigned x, unsigned& nloc, unsigned& nx) {
    const unsigned G = gridDim.x * gridDim.y * gridDim.z;
    unsigned sum, cnt, mine, sp = 0u;
    for (;;) {
        sum = 0u; cnt = 0u; mine = 0u;
#pragma unroll
        for (unsigned j = 0; j < 16; ++j) { const unsigned c = xb_ld(&bar[XB_XCNT(j)]); sum += c; cnt += (c > 0u) ? 1u : 0u; mine = (j == x) ? c : mine; }
        if (sum == G) break;
        __builtin_amdgcn_s_sleep(1);
        if ((++sp & 255u) == 0u) { if (xb_ld(&bar[XB_TMO])) break; if (sp > XB_SPIN_CAP) { atomicAdd(&bar[XB_TMO], 1u); break; } }
    }
    nloc = mine > 0u ? mine : 1u; nx = cnt > 0u ? cnt : 1u;
}
__device__ __forceinline__ void xcd_barrier(const XcdBarrier& b) {
    asm volatile("s_waitcnt vmcnt(0)" ::: "memory");
    __syncthreads();
    if (threadIdx.x == 0) {
        unsigned* bar = b.bar;
        __builtin_amdgcn_s_waitcnt(0);
        unsigned nloc = b.st[0], nx = b.st[1];
        if (nloc == 0u) { xcd_barrier_complete(bar, b.x, nloc, nx); b.st[0] = nloc; b.st[1] = nx; }
        const unsigned old = xb_add(&bar[XB_XSUB(b.x)], 1u);
        const unsigned gen = old / nloc;
        if (old + 1u == (gen + 1u) * nloc) {
            __builtin_amdgcn_fence(__ATOMIC_RELEASE, "agent");
            asm volatile("s_waitcnt vmcnt(0)" ::: "memory");
            const unsigned og = xb_add(&bar[XB_TOP], 1u);
            const unsigned tg = og / nx;
            if (og + 1u == (tg + 1u) * nx) xb_add(&bar[XB_TOPGEN], 1u);
            else XB_SPIN(xb_ld(&bar[XB_TOPGEN]) == tg, bar);
            __builtin_amdgcn_fence(__ATOMIC_ACQUIRE, "agent");
            xb_add(&bar[XB_XGEN(b.x)], 1u);
            asm volatile("s_waitcnt vmcnt(0)" ::: "memory");
        } else {
            XB_SPIN(xb_ld(&bar[XB_XGEN(b.x)]) == gen, bar);
            __builtin_amdgcn_fence(__ATOMIC_ACQUIRE, "agent");
            asm volatile("s_waitcnt vmcnt(0)" ::: "memory");
        }
    }
    __syncthreads();
}


typedef __bf16 bf16x2_t __attribute__((ext_vector_type(2)));
__device__ __forceinline__ unsigned cvt_pk_bf16(float lo, float hi) { const f32x2 v = (f32x2){lo, hi}; const bf16x2_t b = __builtin_convertvector(v, bf16x2_t); return __builtin_bit_cast(unsigned, b); }
__device__ __forceinline__ bf16_t f2bf(float f) { return (bf16_t)(cvt_pk_bf16(f, 0.f) & 0xffffu); }
__device__ __forceinline__ float bf_lo(unsigned w) { return __uint_as_float(w << 16); }
__device__ __forceinline__ float bf_hi(unsigned w) { return __uint_as_float(w & 0xffff0000u); }
__device__ __forceinline__ float bf2f(bf16_t b) { return __uint_as_float(((unsigned)b) << 16); }
__device__ __forceinline__ float sigmoidf_(float x) { return __builtin_amdgcn_rcpf(1.0f + __expf(-x)); }
__device__ __forceinline__ float siluf_(float x) { return x * __builtin_amdgcn_rcpf(1.0f + __expf(-x)); }
template <int CTRL> __device__ __forceinline__ float dpp_mov_f(float x) { return __builtin_bit_cast(float, __builtin_amdgcn_update_dpp(0, __builtin_bit_cast(int, x), CTRL, 0xf, 0xf, true)); }
__device__ __forceinline__ float row16_sum(float v) {
    v += dpp_mov_f<0xB1>(v);
    v += dpp_mov_f<0x4E>(v);
    v += dpp_mov_f<0x141>(v);
    v += dpp_mov_f<0x140>(v);
    return v;
}
__device__ __forceinline__ float wave_sum(float v) {
    v = row16_sum(v);
    const int b = __builtin_bit_cast(int, v);
    const float r0 = __builtin_bit_cast(float, __builtin_amdgcn_readlane(b, 0)), r1 = __builtin_bit_cast(float, __builtin_amdgcn_readlane(b, 16)),
                r2 = __builtin_bit_cast(float, __builtin_amdgcn_readlane(b, 32)), r3 = __builtin_bit_cast(float, __builtin_amdgcn_readlane(b, 48));
    return (r0 + r1) + (r2 + r3);
}
__device__ __forceinline__ u32x2 pack8_fp8(const float (&f)[8]) {
    int a = 0, b = 0;
    a = __builtin_amdgcn_cvt_pk_fp8_f32(f[0], f[1], a, false); a = __builtin_amdgcn_cvt_pk_fp8_f32(f[2], f[3], a, true);
    b = __builtin_amdgcn_cvt_pk_fp8_f32(f[4], f[5], b, false); b = __builtin_amdgcn_cvt_pk_fp8_f32(f[6], f[7], b, true);
    return (u32x2){(unsigned)a, (unsigned)b};
}
__device__ __forceinline__ void unpack8_fp8(const u32x2 w, float (&f)[8]) {
    const f32x2 a = __builtin_amdgcn_cvt_pk_f32_fp8((int)w.x, false), b = __builtin_amdgcn_cvt_pk_f32_fp8((int)w.x, true), c = __builtin_amdgcn_cvt_pk_f32_fp8((int)w.y, false), d = __builtin_amdgcn_cvt_pk_f32_fp8((int)w.y, true);
    f[0] = a.x; f[1] = a.y; f[2] = b.x; f[3] = b.y; f[4] = c.x; f[5] = c.y; f[6] = d.x; f[7] = d.y;
}
__device__ __forceinline__ void unpack8(const u32x4 w, float (&f)[8]) {
    f[0] = bf_lo(w.x); f[1] = bf_hi(w.x); f[2] = bf_lo(w.y); f[3] = bf_hi(w.y);
    f[4] = bf_lo(w.z); f[5] = bf_hi(w.z); f[6] = bf_lo(w.w); f[7] = bf_hi(w.w);
}
__device__ __forceinline__ u32x4 pack8(const float (&f)[8]) {
    u32x4 w; w.x = cvt_pk_bf16(f[0], f[1]); w.y = cvt_pk_bf16(f[2], f[3]); w.z = cvt_pk_bf16(f[4], f[5]); w.w = cvt_pk_bf16(f[6], f[7]); return w;
}

__device__ __forceinline__ void ld16_f32(const GAS float* p, float (&f)[16]) {
#pragma unroll
    for (int i = 0; i < 4; ++i) { const f32x4 v = *(const GAS f32x4*)(p + 4 * i); f[4 * i] = v[0]; f[4 * i + 1] = v[1]; f[4 * i + 2] = v[2]; f[4 * i + 3] = v[3]; }
}
__device__ __forceinline__ void st16_f32(GAS float* p, const float (&f)[16]) {
#pragma unroll
    for (int i = 0; i < 4; ++i) *(GAS f32x4*)(p + 4 * i) = (f32x4){f[4 * i], f[4 * i + 1], f[4 * i + 2], f[4 * i + 3]};
}
__device__ __forceinline__ void ld16_bf16(const GAS bf16_t* p, float (&f)[16]) {
    float a[8], b[8]; unpack8(*(const GAS u32x4*)p, a); unpack8(*(const GAS u32x4*)(p + 8), b);
#pragma unroll
    for (int i = 0; i < 8; ++i) { f[i] = a[i]; f[8 + i] = b[i]; }
}
__device__ __forceinline__ void st16_bf16(GAS bf16_t* p, const float (&f)[16]) {
    const float a[8] = {f[0], f[1], f[2], f[3], f[4], f[5], f[6], f[7]}, b[8] = {f[8], f[9], f[10], f[11], f[12], f[13], f[14], f[15]};
    *(GAS u32x4*)p = pack8(a); *(GAS u32x4*)(p + 8) = pack8(b);
}
__device__ __forceinline__ void st_row_bf16(LAS unsigned char* scr, int lane, GAS bf16_t* rowp, const float (&f)[16]) {
    const float a[8] = {f[0], f[1], f[2], f[3], f[4], f[5], f[6], f[7]}, b[8] = {f[8], f[9], f[10], f[11], f[12], f[13], f[14], f[15]};
    *(LAS u32x4*)(scr + lane * 32) = pack8(a); *(LAS u32x4*)(scr + lane * 32 + 16) = pack8(b);
    const u32x4 c = *(const LAS u32x4*)(scr + lane * 16), d = *(const LAS u32x4*)(scr + 1024 + lane * 16);
    *(GAS u32x4*)((GAS unsigned char*)rowp + lane * 16) = c; *(GAS u32x4*)((GAS unsigned char*)rowp + 1024 + lane * 16) = d;
}
__device__ __forceinline__ void st_row_f32(LAS unsigned char* scr, int lane, GAS float* rowp, const float (&f)[16]) {
#pragma unroll
    for (int i = 0; i < 4; ++i) *(LAS f32x4*)(scr + lane * 64 + i * 16) = (f32x4){f[4 * i], f[4 * i + 1], f[4 * i + 2], f[4 * i + 3]};
    f32x4 v[4];
#pragma unroll
    for (int i = 0; i < 4; ++i) v[i] = *(const LAS f32x4*)(scr + i * 1024 + lane * 16);
#pragma unroll
    for (int i = 0; i < 4; ++i) *(GAS f32x4*)((GAS unsigned char*)rowp + i * 1024 + lane * 16) = v[i];
}
__device__ __forceinline__ void unpack16_fp8(const u32x4 w, float (&f)[16]) {
    float a[8], b[8]; unpack8_fp8((u32x2){w.x, w.y}, a); unpack8_fp8((u32x2){w.z, w.w}, b);
#pragma unroll
    for (int i = 0; i < 8; ++i) { f[i] = a[i]; f[8 + i] = b[i]; }
}
__device__ __forceinline__ u32x4 pack16_fp8(const float (&f)[16]) {
    const float a[8] = {f[0], f[1], f[2], f[3], f[4], f[5], f[6], f[7]}, b[8] = {f[8], f[9], f[10], f[11], f[12], f[13], f[14], f[15]};
    const u32x2 x = pack8_fp8(a), y = pack8_fp8(b); return (u32x4){x.x, x.y, y.x, y.y};
}
struct Args {
    const GAS float* in[24];
    GAS float* out;
    GAS unsigned char* ws;
    int ph_lo, ph_hi;
};
struct Frame {
    LAS unsigned char* lds;
    GAS unsigned char* ws;
    int tid, lane, wave, G, bid;
};

__device__ __forceinline__ Frame refresh(const Frame& F0) {
    Frame F = F0; int t = threadIdx.x; asm volatile("" : "+v"(t)); F.tid = t; { GAS unsigned char* w = F0.ws; asm volatile("" : "+s"(w)); F.ws = w; } { int b = F0.bid, g = F0.G; asm volatile("" : "+s"(b), "+s"(g)); F.bid = b; F.G = g; } F.lane = t & 63; F.wave = __builtin_amdgcn_readfirstlane(t >> 6); return F;
}
__device__ __forceinline__ const GAS float* inp(const Frame& F, int i) {
    unsigned a = (unsigned)(L_PTR + i * 8); asm volatile("" : "+v"(a));
    const unsigned long long v = *(const LAS unsigned long long*)(F.lds + a);
    const unsigned lo = __builtin_amdgcn_readfirstlane((unsigned)v), hi = __builtin_amdgcn_readfirstlane((unsigned)(v >> 32));
    return (const GAS float*)(((unsigned long long)hi << 32) | lo);
}
enum { I_X = 0, I_C, I_CTX, I_CCTX, I_WMOD, I_BMOD, I_WIN, I_WCONV, I_WDU, I_BDEC, I_GN, I_WOUT, I_LN1G, I_LN1B, I_WR, I_RB,
       I_WEG, I_WEU, I_WED, I_WSG, I_WSU, I_WSD, I_LN2G, I_LN2B };

__device__ __forceinline__ void conv_between(LAS unsigned char* lds, GAS unsigned char* ws, int bid, int G, int l, int k);
namespace pg8 {
constexpr int BM = 256, BK = 64, HALF = 128, HTB = HALF * BK * 2, STAGE_BYTES = 8 * HTB, NXCD = 8, WGM = 8;
__device__ __forceinline__ int lds_byte(int r, int c) { const int st = (r >> 4) * 2 + (c >> 5), rr = r & 15, cc = c & 31, ob = rr * 64 + cc * 2; return st * 1024 + (ob ^ (((ob >> 9) & 1) << 5)); }
__device__ __forceinline__ void stage_rc(int b, int& R, int& C) { const int st = b / 1024, sb = b % 1024, swz = sb ^ (((sb >> 9) & 1) << 5); R = (st >> 1) * 16 + swz / 64; C = (st & 1) * 32 + (swz % 64) / 2; }
__device__ __forceinline__ int perm32(int rho) { const int n = rho >> 4, i = rho & 15; return 8 * (i >> 2) + 4 * n + (i & 3); }

struct Unit { int a0, b0, nv, ix; };
typedef int i32x8 __attribute__((ext_vector_type(8)));
__device__ __forceinline__ i32x8 cat8(const bf16x8 a, const bf16x8 b) { const i32x4 x = __builtin_bit_cast(i32x4, a), y = __builtin_bit_cast(i32x4, b); return __builtin_shufflevector(x, y, 0, 1, 2, 3, 4, 5, 6, 7); }
__device__ __forceinline__ bf16x8 lo8(const i32x8 v) { return __builtin_bit_cast(bf16x8, (i32x4)__builtin_shufflevector(v, v, 0, 1, 2, 3)); }
__device__ __forceinline__ bf16x8 hi8(const i32x8 v) { return __builtin_bit_cast(bf16x8, (i32x4)__builtin_shufflevector(v, v, 4, 5, 6, 7)); }

template <class Epi, class Sched, bool FP8 = false>
__device__ __forceinline__ void gemm_phase(LAS unsigned char* lds, const int K_, const Sched& S, const Epi& E) {
    int tid = threadIdx.x; asm volatile("" : "+v"(tid));
    int K = K_; asm volatile("" : "+s"(K));
    const int wid = __builtin_amdgcn_readfirstlane(tid >> 6), lane = tid & 63, wr = wid >> 2, wc = wid & 3, fr = lane & 15, fq = lane >> 4;
    const int nt = K / BK;
    constexpr bool GATHER = Sched::GATHER;
    unsigned voffA[2], voffB[2], rtoff[2];
#pragma unroll
    for (int i = 0; i < 2; ++i) { int R, C; stage_rc(tid * 16 + i * 8192, R, C); const int Rb = Epi::PERM ? ((R & ~31) + perm32(R & 31)) : R;
        voffA[i] = GATHER ? (unsigned)C * 2u : (unsigned)(R * K + C) * 2u; rtoff[i] = (unsigned)R * 4u; voffB[i] = Sched::BTILED ? (unsigned)(Rb * 128 + C * 2) : (unsigned)(Rb * K + C) * 2u; }
    const size_t kstep = (size_t)(BK * 2);
    const size_t hstep = (size_t)HALF * K * 2;
    const size_t kstepB = Sched::BTILED ? (size_t)32768 : kstep, hstepB = Sched::BTILED ? (size_t)16384 : hstep;
    const unsigned ldsw = (unsigned)wid * 1024u;
    const int aoff = lds_byte(wr * 64 + fr, fq * 8), boff = lds_byte(wc * 32 + fr, fq * 8);
#define PG8_SA(b, h) (((b) * 2 + (h)) * HTB)
#define PG8_SB(b, h) ((4 + (b) * 2 + (h)) * HTB)
#define PG8_STAGE(bufoff, gbase, voff) do { _Pragma("unroll") for (int _i = 0; _i < 2; ++_i) \
        __builtin_amdgcn_global_load_lds((const unsigned*)((const char*)(gbase) + (voff)[_i]), (LAS unsigned*)(lds + (bufoff) + ldsw + _i * 8192), 16, 0, 0); } while (0)
#define PG8_STAGE_A(bufoff, kp, h) do { if constexpr (GATHER) { if ((h) == 0) PG8_STAGE(bufoff, kp, ga0); else PG8_STAGE(bufoff, kp, ga1); } \
        else { PG8_STAGE(bufoff, (kp) + ((h) ? hstep : 0), voffA); } } while (0)
#define PG8_LDA(dst, b, h) do { _Pragma("unroll") for (int m = 0; m < 4; ++m) dst[m] = cat8(*(const LAS bf16x8*)(lds + PG8_SA(b, h) + aoff + m * 2048), *(const LAS bf16x8*)(lds + PG8_SA(b, h) + aoff + m * 2048 + 1024)); } while (0)
#define PG8_LDB(dst, b, h) do { _Pragma("unroll") for (int n = 0; n < 2; ++n) dst[n] = cat8(*(const LAS bf16x8*)(lds + PG8_SB(b, h) + boff + n * 2048), *(const LAS bf16x8*)(lds + PG8_SB(b, h) + boff + n * 2048 + 1024)); } while (0)
#define PG8_MMA(ai, bj, At, Bt) do { __builtin_amdgcn_s_setprio(1); _Pragma("unroll") for (int m = 0; m < 4; ++m) _Pragma("unroll") for (int n = 0; n < 2; ++n) { \
        if constexpr (FP8) { acc[ai][bj][m][n] = __builtin_amdgcn_mfma_scale_f32_16x16x128_f8f6f4(Bt[n], At[m], acc[ai][bj][m][n], 0, 0, 0, 0x7a7a7a7a, 0, 0x7f7f7f7f); } \
        else { acc[ai][bj][m][n] = __builtin_amdgcn_mfma_f32_16x16x32_bf16(lo8(Bt[n]), lo8(At[m]), acc[ai][bj][m][n], 0, 0, 0); \
               acc[ai][bj][m][n] = __builtin_amdgcn_mfma_f32_16x16x32_bf16(hi8(Bt[n]), hi8(At[m]), acc[ai][bj][m][n], 0, 0, 0); } } \
        __builtin_amdgcn_s_setprio(0); } while (0)
#define PG8_WAIT_V(n) asm volatile("s_waitcnt vmcnt(" #n ")" ::: "memory")
#define PG8_WAIT_L(n) asm volatile("s_waitcnt lgkmcnt(" #n ")" ::: "memory")
#define PG8_BAR __builtin_amdgcn_s_barrier()
#define PG8_SCHED __builtin_amdgcn_sched_barrier(0)
    Unit cur, nxt; int ui = 0; bool pexact = false;
    if (!S.next(0, cur)) return;
    f32x4 acc[2][2][4][2];
#pragma unroll
    for (int a = 0; a < 2; ++a)
#pragma unroll
        for (int b = 0; b < 2; ++b)
#pragma unroll
            for (int m = 0; m < 4; ++m)
#pragma unroll
                for (int n = 0; n < 2; ++n) acc[a][b][m][n] = (f32x4){0.f, 0.f, 0.f, 0.f};
    i32x8 At[4], B0[2], B1[2];
    unsigned ga0[2] = {0u, 0u}, ga1[2] = {0u, 0u};
    if constexpr (GATHER) {
#pragma unroll
        for (int i = 0; i < 2; ++i) { ga0[i] = S.arow(cur, rtoff[i]) + voffA[i]; ga1[i] = S.arow(cur, rtoff[i] + HALF * 4) + voffA[i]; }
    }
    const char* cA = S.aptr(cur);
    const char* cB = S.bptr(cur);
    PG8_STAGE(PG8_SB(0, 0), cB, voffB); PG8_STAGE_A(PG8_SA(0, 0), cA, 0); PG8_STAGE(PG8_SB(0, 1), cB + hstepB, voffB); PG8_STAGE_A(PG8_SA(0, 1), cA, 1);
    if (wr == 1) PG8_BAR;
    PG8_WAIT_V(4); PG8_BAR;
    PG8_STAGE(PG8_SB(1, 0), cB + kstepB, voffB); PG8_STAGE_A(PG8_SA(1, 0), cA + kstep, 0); PG8_STAGE(PG8_SB(1, 1), cB + hstepB + kstepB, voffB);
    PG8_WAIT_V(6); PG8_BAR;
    for (;;) {
        const bool has_next = S.next(ui + 1, nxt);
        const char* nA = has_next ? S.aptr(nxt) : cA; const char* nB = has_next ? S.bptr(nxt) : cB;
        const bool do_lo = (wr == 0) || cur.nv > 64, do_hi = cur.nv > 128;
        for (int t = 0; t < nt; t += 2) {
            const bool last = (t == nt - 2);
            const bool pre = Epi::PRE && (t == 0) && (ui > 0);
            const char* a1 = cA + (size_t)(t + 1) * kstep;
            const char* a2 = last ? nA : cA + (size_t)(t + 2) * kstep; const char* b2 = last ? nB : cB + (size_t)(t + 2) * kstepB;
            const char* a3 = a2 + kstep; const char* b3 = b2 + kstepB;
            PG8_LDB(B0, 0, 0); PG8_SCHED; PG8_LDA(At, 0, 0); if (!pre) PG8_STAGE_A(PG8_SA(1, 1), a1, 1);
            PG8_WAIT_L(8); PG8_BAR; PG8_WAIT_L(0); if (do_lo) PG8_MMA(0, 0, At, B0); PG8_BAR; PG8_SCHED;
            if constexpr (GATHER) { if (last && has_next) {
#pragma unroll
                for (int i = 0; i < 2; ++i) { ga0[i] = S.arow(nxt, rtoff[i]) + voffA[i]; ga1[i] = S.arow(nxt, rtoff[i] + HALF * 4) + voffA[i]; } } }
            PG8_LDB(B1, 0, 1); PG8_STAGE(PG8_SB(0, 0), b2, voffB);
            PG8_BAR; PG8_WAIT_L(0); if (do_lo) PG8_MMA(0, 1, At, B1); PG8_BAR;
            if (do_hi) PG8_LDA(At, 0, 1); PG8_STAGE_A(PG8_SA(0, 0), a2, 0);
            PG8_BAR; PG8_WAIT_L(0); if (do_hi) PG8_MMA(1, 0, At, B0); PG8_BAR; PG8_SCHED;
            PG8_STAGE(PG8_SB(0, 1), b2 + hstepB, voffB);
            if (pre && pexact) { if constexpr (Epi::NST == 8) PG8_WAIT_V(14); else if constexpr (Epi::NST == 16) PG8_WAIT_V(22); else if constexpr (Epi::NST == 32) PG8_WAIT_V(38); else PG8_WAIT_V(6); }
            else PG8_WAIT_V(6);
            PG8_BAR; if (do_hi) PG8_MMA(1, 1, At, B1); PG8_BAR;
            PG8_LDB(B0, 1, 0); PG8_SCHED; PG8_LDA(At, 1, 0); PG8_STAGE_A(PG8_SA(0, 1), a2, 1);
            PG8_WAIT_L(8); PG8_BAR; PG8_WAIT_L(0); if (do_lo) PG8_MMA(0, 0, At, B0); PG8_BAR; PG8_SCHED;
            PG8_LDB(B1, 1, 1); PG8_STAGE(PG8_SB(1, 0), b3, voffB);
            PG8_BAR; PG8_WAIT_L(0); if (do_lo) PG8_MMA(0, 1, At, B1); PG8_BAR;
            if (do_hi) PG8_LDA(At, 1, 1); PG8_STAGE_A(PG8_SA(1, 0), a3, 0);
            PG8_BAR; PG8_WAIT_L(0); if (do_hi) PG8_MMA(1, 0, At, B0); PG8_BAR; PG8_SCHED;
            PG8_STAGE(PG8_SB(1, 1), b3 + hstepB, voffB);
            PG8_WAIT_V(6); PG8_BAR; if (do_hi) PG8_MMA(1, 1, At, B1); PG8_BAR;
        }
        if constexpr (Epi::PRE) PG8_STAGE_A(PG8_SA(1, 1), nA + kstep, 1);
        E(acc, cur, wr, wc, fr, fq);
        if constexpr (Epi::PRE) pexact = E.exact(cur);
        S.between(ui);
        if (!has_next) break;
#pragma unroll
        for (int a = 0; a < 2; ++a)
#pragma unroll
            for (int b = 0; b < 2; ++b)
#pragma unroll
                for (int m = 0; m < 4; ++m)
#pragma unroll
                    for (int n = 0; n < 2; ++n) acc[a][b][m][n] = (f32x4){0.f, 0.f, 0.f, 0.f};
        cur = nxt; cA = nA; cB = nB; ++ui;
    }
    PG8_WAIT_V(0);
    if (wr == 0) PG8_BAR;
    PG8_BAR;
#undef PG8_SA
#undef PG8_SB
#undef PG8_STAGE
#undef PG8_STAGE_A
#undef PG8_LDA
#undef PG8_LDB
#undef PG8_MMA
#undef PG8_WAIT_V
#undef PG8_WAIT_L
#undef PG8_BAR
#undef PG8_SCHED
}

struct DenseOrder {
    static constexpr bool GATHER = false, BTILED = false;
    __device__ __forceinline__ void between(int) const {}
    int nM, nN, nwg, G, c, K; const char* A; const char* Bt;
    __device__ void init(int M, int N, int K_, const char* A_, const char* Bt_, int G_, int c_) { nM = M / BM; nN = N / BM; nwg = nM * nN; G = G_; c = c_; K = K_; A = (const char*)A_; Bt = (const char*)Bt_; }
    __device__ __forceinline__ bool next(int i, Unit& u) const {
        const long L = (long)i * G + c; if (L >= nwg) return false;
        int wgid = (int)L; { const int q = nwg / NXCD, r = nwg % NXCD, xcd = wgid % NXCD, off = wgid / NXCD; wgid = (xcd < r ? xcd * (q + 1) : r * (q + 1) + (xcd - r) * q) + off; }
        const int nig = WGM * nN, gid = wgid / nig, fm = gid * WGM, gsz = (nM - fm) < WGM ? (nM - fm) : WGM;
        u.a0 = fm + ((wgid % nig) % gsz); u.b0 = (wgid % nig) / gsz; u.nv = 256; u.ix = 0; return true;
    }
    __device__ __forceinline__ unsigned arow(const Unit&, unsigned) const { return 0u; }
    __device__ __forceinline__ const char* aptr(const Unit& u) const { return A + (size_t)u.a0 * BM * K * 2; }
    __device__ __forceinline__ const char* bptr(const Unit& u) const { return Bt + (size_t)u.b0 * BM * K * 2; }
};

struct Group1Order {
    static constexpr bool GATHER = true, BTILED = true;
    __device__ __forceinline__ void between(int) const {}
    LAS unsigned char* lds; const char* A; const char* Bt;
    __device__ __forceinline__ bool next(int i, Unit& u) const {
        const int n = __builtin_amdgcn_readfirstlane(*(const LAS int*)(lds + L_NMY)); if (i >= n) return false;
        const i32x4 t = *(const LAS i32x4*)(lds + L_UTAB + i * 16);
        const int tx = __builtin_amdgcn_readfirstlane(t.x), ty = __builtin_amdgcn_readfirstlane(t.y), tz = __builtin_amdgcn_readfirstlane(t.z), tw = __builtin_amdgcn_readfirstlane(t.w);
        u.a0 = ty; u.b0 = tx * 2 + tw; u.nv = tz; u.ix = i; return true;
    }
    __device__ __forceinline__ unsigned arow(const Unit& u, unsigned r4) const { return *(const LAS unsigned*)(lds + L_ROWTAB + u.ix * 1024 + r4); }
    __device__ __forceinline__ const char* aptr(const Unit&) const { return A; }
    __device__ __forceinline__ const char* bptr(const Unit& u) const { return Bt + (size_t)u.b0 * 8 * 32768; }
};
struct Group2Order {
    static constexpr bool GATHER = true, BTILED = true;
    __device__ __forceinline__ void between(int) const {}
    LAS unsigned char* lds; const char* A; const char* Bt;
    __device__ __forceinline__ bool next(int i, Unit& u) const {
        const int n = __builtin_amdgcn_readfirstlane(*(const LAS int*)(lds + L_NMY)); if (i >= n) return false;
        const i32x4 t = *(const LAS i32x4*)(lds + L_UTAB + i * 16);
        const int tx = __builtin_amdgcn_readfirstlane(t.x), ty = __builtin_amdgcn_readfirstlane(t.y), tz = __builtin_amdgcn_readfirstlane(t.z), tw = __builtin_amdgcn_readfirstlane(t.w);
        u.a0 = ty; u.b0 = tx * 4 + tw; u.nv = tz; u.ix = tw; return true;
    }
    __device__ __forceinline__ unsigned arow(const Unit& u, unsigned r4) const { return (unsigned)u.a0 * 256u + r4 * 64u; }
    __device__ __forceinline__ const char* aptr(const Unit&) const { return A; }
    __device__ __forceinline__ const char* bptr(const Unit& u) const { return Bt + (size_t)u.b0 * 2 * 32768; }
};
struct DenseTabOrder {
    static constexpr bool GATHER = true, BTILED = true;
    LAS unsigned char* lds; const char* A; const char* Bt; int rowbytes;
    GAS unsigned char* cws; int cbid, cG, clayer, ck0, cn;
    __device__ __forceinline__ void between(int ui) const { if (ui < cn) conv_between(lds, cws, cbid, cG, clayer, ck0 + ui); }
    __device__ __forceinline__ bool next(int i, Unit& u) const {
        const int n = __builtin_amdgcn_readfirstlane(*(const LAS int*)(lds + L_NMY)); if (i >= n) return false;
        const i32x4 t = *(const LAS i32x4*)(lds + L_UTAB + i * 16);
        u.a0 = __builtin_amdgcn_readfirstlane(t.y); u.b0 = __builtin_amdgcn_readfirstlane(t.x); u.nv = 256; u.ix = i; return true;
    }
    __device__ __forceinline__ unsigned arow(const Unit& u, unsigned r4) const { return *(const LAS unsigned*)(lds + L_ROWTAB + u.ix * 1024 + r4); }
    __device__ __forceinline__ const char* aptr(const Unit&) const { return A; }
    __device__ __forceinline__ const char* bptr(const Unit& u) const { return Bt + (size_t)u.b0 * (rowbytes / 128) * 32768; }
};

struct EpiBf16 {
    static constexpr bool PERM = true, PRE = false; static constexpr int NST = 16;
    __device__ __forceinline__ bool exact(const Unit&) const { return true; }
    bf16_t* O; int ldc; int ncol;
    __device__ __forceinline__ void operator()(const f32x4 (&acc)[2][2][4][2], const Unit& u, int, int, int, int) const {
        int tz = threadIdx.x; asm volatile("" : "+v"(tz)); const int wid = tz >> 6, lane = tz & 63, wr = wid >> 2, wc = wid & 3, fr = lane & 15, fq = lane >> 4;
        const int row0 = u.a0 * BM + wr * 64 + fr, col0 = u.b0 * BM + wc * 32 + 8 * fq;
#pragma unroll
        for (int ai = 0; ai < 2; ++ai)
#pragma unroll
            for (int m = 0; m < 4; ++m) { bf16_t* rowp = O + (size_t)(row0 + ai * HALF + m * 16) * ldc + col0;
#pragma unroll
                for (int bj = 0; bj < 2; ++bj) { if (col0 + bj * HALF < ncol) {
                    const f32x4 v0 = acc[ai][bj][m][0], v1 = acc[ai][bj][m][1];
                    u32x4 w; w.x = cvt_pk_bf16(v0[0], v0[1]); w.y = cvt_pk_bf16(v0[2], v0[3]); w.z = cvt_pk_bf16(v1[0], v1[1]); w.w = cvt_pk_bf16(v1[2], v1[3]);
                    *(u32x4*)(rowp + bj * HALF) = w; } } }
    }
};
struct EpiF32 {
    static constexpr bool PERM = false, PRE = false; static constexpr int NST = 32;
    __device__ __forceinline__ bool exact(const Unit&) const { return true; }
    float* C; int ldc;
    __device__ __forceinline__ void operator()(const f32x4 (&acc)[2][2][4][2], const Unit& u, int, int, int, int) const {
        int tz = threadIdx.x; asm volatile("" : "+v"(tz)); const int wid = tz >> 6, lane = tz & 63, wr = wid >> 2, wc = wid & 3, fr = lane & 15, fq = lane >> 4;
        const int row0 = u.a0 * BM + wr * 64 + fr, col0 = u.b0 * BM + wc * 32 + 4 * fq;
#pragma unroll
        for (int ai = 0; ai < 2; ++ai)
#pragma unroll
            for (int m = 0; m < 4; ++m) { float* rowp = C + (size_t)(row0 + ai * HALF + m * 16) * ldc + col0;
#pragma unroll
                for (int bj = 0; bj < 2; ++bj)
#pragma unroll
                    for (int n = 0; n < 2; ++n) *(f32x4*)(rowp + bj * HALF + n * 16) = acc[ai][bj][m][n]; }
    }
};
struct EpiSwiGLU {
    static constexpr bool PERM = true, PRE = true; static constexpr int NST = 8;
    __device__ __forceinline__ bool exact(const Unit&) const { return true; }
    unsigned char* H;
    __device__ __forceinline__ void operator()(const f32x4 (&acc)[2][2][4][2], const Unit& u, int, int, int, int) const {
        int tz = threadIdx.x; asm volatile("" : "+v"(tz)); const int wid = tz >> 6, lane = tz & 63, wr = wid >> 2, wc = wid & 3, fr = lane & 15, fq = lane >> 4;
        const int sub = u.b0 & 1;
        const int col0 = sub * 128 + wc * 32 + 8 * fq;
#pragma unroll
        for (int ai = 0; ai < 2; ++ai)
#pragma unroll
            for (int m = 0; m < 4; ++m) { const int r = ai * HALF + wr * 64 + m * 16 + fr;
                float h[8];
#pragma unroll
                for (int n = 0; n < 2; ++n)
#pragma unroll
                    for (int j = 0; j < 4; ++j) { const float g = acc[ai][0][m][n][j], up = acc[ai][1][m][n][j]; h[n * 4 + j] = siluf_(g) * up; }
                *(u32x2*)(H + (size_t)(u.a0 + r) * 256 + col0) = pack8_fp8(h); }
    }
};
struct EpiY {
    static constexpr bool PERM = true, PRE = true; static constexpr int NST = 8;
    __device__ __forceinline__ bool exact(const Unit& u) const { return u.nv == 256; }
    unsigned char* Y;
    __device__ __forceinline__ void operator()(const f32x4 (&acc)[2][2][4][2], const Unit& u, int, int, int, int) const {
        int tz = threadIdx.x; asm volatile("" : "+v"(tz)); const int wid = tz >> 6, lane = tz & 63, wr = wid >> 2, wc = wid & 3, fr = lane & 15, fq = lane >> 4;
        const int col0 = u.ix * 256 + wc * 64 + 16 * fq;
#pragma unroll
        for (int ai = 0; ai < 2; ++ai)
#pragma unroll
            for (int m = 0; m < 4; ++m) { const int r = ai * HALF + wr * 64 + m * 16 + fr;
                if (r < u.nv) { unsigned char* rowp = Y + (size_t)(u.a0 + r) * 1024 + col0;
                    const f32x4 v0 = acc[ai][0][m][0], v1 = acc[ai][0][m][1], v2 = acc[ai][1][m][0], v3 = acc[ai][1][m][1];
                    const float f[8] = {v0[0], v0[1], v0[2], v0[3], v1[0], v1[1], v1[2], v1[3]}, g[8] = {v2[0], v2[1], v2[2], v2[3], v3[0], v3[1], v3[2], v3[3]};
                    const u32x2 a = pack8_fp8(f), b = pack8_fp8(g);
                    *(u32x4*)rowp = (u32x4){a.x, a.y, b.x, b.y}; } }
    }
};
}

template <int SUB, bool ROWS>
__device__ __forceinline__ void build_group_tables(const Frame& F0) {
    const Frame F = refresh(F0);
    const GAS i32x4* MT = (const GAS i32x4*)(F.ws + WS_MT);
    const int nmt = *(const GAS int*)(F.ws + WS_MT + 1536 * 16);
    const GAS int* STOK = (const GAS int*)(F.ws + WS_STOK);
    const int nwg = nmt * SUB;
    __syncthreads();
    if (F.tid < 24) {
        const long L = (long)F.tid * F.G + F.bid;
        i32x4 e = (i32x4){0, 0, 0, 0};
        if (L < nwg) {
            int wgid = (int)L; { const int q = nwg / 8, r = nwg % 8, xcd = wgid % 8, off = wgid / 8; wgid = (xcd < r ? xcd * (q + 1) : r * (q + 1) + (xcd - r) * q) + off; }
            const i32x4 t = MT[wgid / SUB]; e = (i32x4){t.x, t.y, t.z, wgid % SUB};
        }
        *(LAS i32x4*)(F.lds + L_UTAB + F.tid * 16) = e;
    }
    if (F.tid == 0) *(LAS int*)(F.lds + L_NMY) = nwg > F.bid ? (nwg - F.bid + F.G - 1) / F.G : 0;
    __syncthreads();
    if (ROWS) {
        const int n = *(const LAS int*)(F.lds + L_NMY);
        int tok[8];
#pragma unroll
        for (int j = 0; j < 8; ++j) { const int p = F.tid + 512 * j; tok[j] = 0;
            if (p < n * 256) { const int i = p >> 8, r = p & 255; const i32x4 t = *(const LAS i32x4*)(F.lds + L_UTAB + i * 16);
                if (t.x == NEXP) tok[j] = t.y - SH_BASE + r; else if (r < t.z) tok[j] = STOK[t.y + r]; } }
#pragma unroll
        for (int j = 0; j < 8; ++j) { const int p = F.tid + 512 * j; if (p < n * 256) *(LAS unsigned*)(F.lds + L_ROWTAB + p * 4) = (unsigned)tok[j] * 1024u; }
        __syncthreads();
    }
}

__device__ __forceinline__ void build_dense_tables(const Frame& F0, int M, int N, int rowbytes, int pm0 = 0) {
    const Frame F = refresh(F0);
    pg8::DenseOrder D; D.init(M, N, 0, nullptr, nullptr, F.G, F.bid);
    __syncthreads();
    if (F.tid < 24) { pg8::Unit u; i32x4 e = (i32x4){0, 0, 0, 0}; if (D.next(F.tid, u)) e = (i32x4){u.b0, u.a0 + pm0, 256, 0};
        *(LAS i32x4*)(F.lds + L_UTAB + F.tid * 16) = e; }
    if (F.tid == 0) *(LAS int*)(F.lds + L_NMY) = D.nwg > F.bid ? (D.nwg - F.bid + F.G - 1) / F.G : 0;
    __syncthreads();
    const int n = *(const LAS int*)(F.lds + L_NMY);
    for (int p = F.tid; p < n * 256; p += 512) { const int i = p >> 8, r = p & 255;
        const i32x4 t = *(const LAS i32x4*)(F.lds + L_UTAB + i * 16);
        *(LAS unsigned*)(F.lds + L_ROWTAB + p * 4) = (unsigned)(t.y * 256 + r) * (unsigned)rowbytes; }
    __syncthreads();
}

template <int MAP>
__device__ __forceinline__ void conv_job(const Frame& F, const GAS float* src, int K, int N, int nmat, size_t src_stride, GAS bf16_t* dst, size_t dst_stride, int ldd, int rot) {
    const int nk = K / 64, nn = (N + 255) / 256, per = nk * nn, total = per * nmat;
    for (int t = (F.bid + rot) % F.G; t < total; t += F.G) {
        const int mtx = t / per, r = t % per, kt = r / nn, ntile = r % nn;
        const int k0 = kt * 64 + F.wave * 8, n4 = ntile * 256 + F.lane * 4;
        if (n4 < N) {
            const GAS float* p = src + (size_t)mtx * src_stride + (size_t)k0 * N + n4;
            f32x4 v[8];
#pragma unroll
            for (int i = 0; i < 8; ++i) v[i] = *(const GAS f32x4*)(p + (size_t)i * N);
            GAS bf16_t* dm = dst + (size_t)mtx * dst_stride;
#pragma unroll
            for (int q = 0; q < 4; ++q) {
                const int gn = n4 + q;
                const int row = MAP == 0 ? gn : (MAP == 1 ? ((gn & 127) + 256 * (gn >> 7)) : (128 + (gn & 127) + 256 * (gn >> 7)));
                u32x4 w; w.x = cvt_pk_bf16(v[0][q], v[1][q]); w.y = cvt_pk_bf16(v[2][q], v[3][q]); w.z = cvt_pk_bf16(v[4][q], v[5][q]); w.w = cvt_pk_bf16(v[6][q], v[7][q]);
                *(GAS u32x4*)(dm + (size_t)row * ldd + k0) = w;
            }
        }
    }
}
template <int MAP>
__device__ __forceinline__ void conv_job8(const Frame& F, const GAS float* src, int K, int N, int rows_total, int nmat, size_t src_stride, GAS unsigned char* dst, size_t dst_stride, int rot) {
    const int nk = K / 128, nn = (N + 255) / 256, per = nk * nn, total = per * nmat;
    for (int t = (F.bid + rot) % F.G; t < total; t += F.G) {
        const int mtx = t / per, r = t % per, kt = r / nn, ntile = r % nn;
        const int k0 = kt * 128 + (F.lane >> 3) * 16, n4 = ntile * 256 + F.wave * 32 + (F.lane & 7) * 4;
        f32x4 v[16];
        if (n4 < N) {
            const GAS float* p = src + (size_t)mtx * src_stride + (size_t)k0 * N + n4;
#pragma unroll
            for (int i = 0; i < 16; ++i) v[i] = __builtin_nontemporal_load((const GAS f32x4*)(p + (size_t)i * N));
        } else {
#pragma unroll
            for (int i = 0; i < 16; ++i) v[i] = (f32x4){0.f, 0.f, 0.f, 0.f};
        }
        GAS unsigned char* dm = dst + (size_t)mtx * dst_stride;
#pragma unroll
        for (int q = 0; q < 4; ++q) {
            const int gn = n4 + q;
            const int row = MAP == 0 ? gn : (MAP == 1 ? ((gn & 127) + 256 * (gn >> 7)) : (128 + (gn & 127) + 256 * (gn >> 7)));
            if (row < rows_total) {
                int w[4];
#pragma unroll
                for (int d = 0; d < 4; ++d) { int x = 0;
                    x = __builtin_amdgcn_cvt_pk_fp8_f32(v[4 * d][q] * 32.f, v[4 * d + 1][q] * 32.f, x, false);
                    x = __builtin_amdgcn_cvt_pk_fp8_f32(v[4 * d + 2][q] * 32.f, v[4 * d + 3][q] * 32.f, x, true); w[d] = x; }
                *(GAS u32x4*)(dm + ((size_t)((row >> 8) * nk + kt) * 256 + (row & 255)) * 128 + (F.lane >> 3) * 16) = (u32x4){(unsigned)w[0], (unsigned)w[1], (unsigned)w[2], (unsigned)w[3]};
            }
        }
    }
}
__device__ __forceinline__ void phase_weights(const Frame& F0, const Args& A, int l) {
    const Frame F = refresh(F0);
    conv_job8<0>(F, inp(F, I_WIN) + (size_t)l * 1024 * INC, 1024, INC, INCP, 1, 0, (GAS unsigned char*)(F.ws + WS_WIN), 0, 0);
    conv_job8<0>(F, inp(F, I_WOUT) + (size_t)l * 1024 * 1024, 1024, 1024, 1024, 1, 0, (GAS unsigned char*)(F.ws + WS_WOUT), 0, 104);
    conv_job<0>(F, inp(F, I_WR) + (size_t)l * 1024 * 256, 1024, 256, 1, 0, (GAS bf16_t*)(F.ws + WS_WR), 0, 1024, 136);
}
constexpr int NCONV_ITEMS = 2048 + 2048 + 2048 + 24;
constexpr int CONV_TAIL = 4, CONV_FRONT = 24 - CONV_TAIL;
struct ConvItem { const GAS float* src; GAS unsigned char* dst; int N, map, nk, kt, ntile; };
__device__ __forceinline__ ConvItem conv_item(const Frame& F, int l, int idx) {
    ConvItem c;
    GAS unsigned char* BT1 = (GAS unsigned char*)(F.ws + WS_BT1); GAS unsigned char* BT2 = (GAS unsigned char*)(F.ws + WS_BT2);
    if (idx < 4096) {
        const int up = idx >> 11, j = idx & 2047, e = j >> 3;
        c.src = inp(F, up ? I_WEU : I_WEG) + ((size_t)l * 256 + e) * 1024 * 256; c.dst = BT1 + (size_t)e * 512 * 1024;
        c.N = 256; c.map = 1 + up; c.nk = 8; c.kt = j & 7; c.ntile = 0;
    } else if (idx < 6144) {
        const int j = idx - 4096, e = j >> 3, r = j & 7;
        c.src = inp(F, I_WED) + ((size_t)l * 256 + e) * 256 * 1024; c.dst = BT2 + (size_t)e * 1024 * 256;
        c.N = 1024; c.map = 3; c.nk = 2; c.kt = r >> 2; c.ntile = r & 3;
    } else {
        const int j = idx - 6144, which = j >> 3, r = j & 7;
        if (which < 2) { c.src = inp(F, which ? I_WSU : I_WSG) + (size_t)l * 1024 * 256; c.dst = BT1 + (size_t)256 * 512 * 1024; c.N = 256; c.map = 1 + which; c.nk = 8; c.kt = r; c.ntile = 0; }
        else { c.src = inp(F, I_WSD) + (size_t)l * 256 * 1024; c.dst = BT2 + (size_t)256 * 1024 * 256; c.N = 1024; c.map = 3; c.nk = 2; c.kt = r >> 2; c.ntile = r & 3; }
    }
    return c;
}
struct ConvRegs { f32x4 v[16]; };
__device__ __forceinline__ void conv_issue(const Frame& F, const ConvItem& c, ConvRegs& R) {
    const GAS float* p = c.src + (size_t)(c.kt * 128 + (F.lane >> 3) * 16) * c.N + c.ntile * 256 + F.wave * 32 + (F.lane & 7) * 4;
#pragma unroll
    for (int i = 0; i < 16; ++i) R.v[i] = __builtin_nontemporal_load((const GAS f32x4*)(p + (size_t)i * c.N));
}
__device__ __forceinline__ void conv_finish(const Frame& F, const ConvItem& c, const ConvRegs& R) {
#pragma unroll
    for (int q = 0; q < 4; ++q) {
        const int gn = c.ntile * 256 + F.wave * 32 + (F.lane & 7) * 4 + q;
        int row;
        if (c.map == 0) row = gn;
        else if (c.map == 1) row = (gn & 127) + 256 * (gn >> 7);
        else if (c.map == 2) row = 128 + (gn & 127) + 256 * (gn >> 7);
        else { const int o = gn & 255; row = (gn & ~255) + 128 * ((o >> 3) & 1) + 32 * (o >> 6) + 8 * ((o >> 4) & 3) + (o & 7); }
        int w[4];
#pragma unroll
        for (int d = 0; d < 4; ++d) { int x = 0;
            x = __builtin_amdgcn_cvt_pk_fp8_f32(R.v[4 * d][q] * 32.f, R.v[4 * d + 1][q] * 32.f, x, false);
            x = __builtin_amdgcn_cvt_pk_fp8_f32(R.v[4 * d + 2][q] * 32.f, R.v[4 * d + 3][q] * 32.f, x, true); w[d] = x; }
        *(GAS u32x4*)(c.dst + ((size_t)((row >> 8) * c.nk + c.kt) * 256 + (row & 255)) * 128 + (F.lane >> 3) * 16) = (u32x4){(unsigned)w[0], (unsigned)w[1], (unsigned)w[2], (unsigned)w[3]};
    }
}
__device__ __forceinline__ void conv_run(const Frame& F, int l, int first, int count) {
    for (int k = first; k < first + count; ++k) { const int idx = F.bid + k * F.G; if (idx >= NCONV_ITEMS) break;
        const ConvItem c = conv_item(F, l, idx); ConvRegs R; conv_issue(F, c, R); conv_finish(F, c, R); }
}
__device__ __forceinline__ void conv_between(LAS unsigned char* lds, GAS unsigned char* ws, int bid, int G, int l, int k) {
    const int idx = bid + k * G; if (idx >= NCONV_ITEMS) return;
    Frame F; F.lds = lds; F.ws = ws; F.bid = bid; F.G = G; { int t = threadIdx.x; asm volatile("" : "+v"(t)); F.tid = t; F.lane = t & 63; F.wave = __builtin_amdgcn_readfirstlane(t >> 6); }
    const ConvItem c = conv_item(F, l, idx); ConvRegs R; conv_issue(F, c, R); conv_finish(F, c, R);
}
__device__ __forceinline__ void phase_mod(const Frame& F0, const Args& A) {
    const Frame F = refresh(F0);
    LAS float* sc = (LAS float*)F.lds;
    LAS float* red = sc + 5 * 1024;
    GAS float* MOD = (GAS float*)(F.ws + WS_MOD);
    __syncthreads();
    for (int i = F.tid; i < 5 * 1024; i += 512) { const int r = i >> 10, k = i & 1023; const float v = r < 4 ? inp(F, I_C)[r * 1024 + k] : inp(F, I_CCTX)[k]; sc[i] = siluf_(v); }
    __syncthreads();
    const int col = F.tid & 31, ks = F.tid >> 5;
    for (int task = F.bid; task < 2 * 192; task += F.G) {
        const int l = task / 192, c0 = (task % 192) * 32;
        const GAS float* W = inp(F, I_WMOD) + (size_t)l * 1024 * 6144 + c0 + col;
        float a0 = 0.f, a1 = 0.f, a2 = 0.f, a3 = 0.f, a4 = 0.f;
        for (int kb = ks * 64; kb < ks * 64 + 64; kb += 16) {
            float w[16];
#pragma unroll
            for (int q = 0; q < 16; ++q) w[q] = W[(size_t)(kb + q) * 6144];
#pragma unroll
            for (int q = 0; q < 16; ++q) { const int k = kb + q;
                a0 += sc[k] * w[q]; a1 += sc[1024 + k] * w[q]; a2 += sc[2048 + k] * w[q]; a3 += sc[3072 + k] * w[q]; a4 += sc[4096 + k] * w[q]; } }
        red[(ks * 5 + 0) * 32 + col] = a0; red[(ks * 5 + 1) * 32 + col] = a1; red[(ks * 5 + 2) * 32 + col] = a2; red[(ks * 5 + 3) * 32 + col] = a3; red[(ks * 5 + 4) * 32 + col] = a4;
        __syncthreads();
        if (F.tid < 160) { const int r = F.tid >> 5, c = F.tid & 31; float s = inp(F, I_BMOD)[l * 6144 + c0 + c];
            for (int q = 0; q < 16; ++q) s += red[(q * 5 + r) * 32 + c];
            MOD[((size_t)l * 5 + r) * 6144 + c0 + c] = s; }
        __syncthreads();
    }
}
__device__ __forceinline__ int row_lo(int l) { return l == DEPTH - 1 ? NCTX : 0; }
__device__ __forceinline__ int mod_row(int row) { return row < NCTX ? 4 : ((row - NCTX) >> 13); }
__device__ __forceinline__ const GAS float* xrow_ptr(const Frame& F, const Args& A, int l, int row) {
    if (l == 0) return row < NCTX ? inp(F, I_CTX) + (size_t)row * 1024 : inp(F, I_X) + (size_t)(row - NCTX) * 1024;
    return (const GAS float*)(F.ws + WS_XS) + (size_t)row * 1024;
}
template <int NV>
__device__ __forceinline__ void mod_cache_fill(const Frame& F, LAS float* mc, const GAS float* MODL, const int (&voff)[NV]) {
    __syncthreads();
    for (int idx = F.tid; idx < 5 * NV * 1024; idx += 512) {
        const int rv = idx >> 10, e = idx & 1023, r = rv / NV, v = rv % NV;
        mc[rv * 1024 + ((e >> 2) & 3) * 256 + (e >> 4) * 4 + (e & 3)] = MODL[(size_t)r * 6144 + voff[v] + e];
    }
    __syncthreads();
}
__device__ __forceinline__ void mod_cache_ld(const LAS float* vec, int lane, float (&f)[16]) {
#pragma unroll
    for (int i = 0; i < 4; ++i) { const f32x4 t = *(const LAS f32x4*)(vec + i * 256 + lane * 4); f[4 * i] = t[0]; f[4 * i + 1] = t[1]; f[4 * i + 2] = t[2]; f[4 * i + 3] = t[3]; }
}
__device__ __forceinline__ void phase_modulate0(const Frame& F0, const Args& A) {
    const Frame F = refresh(F0);
    const GAS float* MOD = (const GAS float*)(F.ws + WS_MOD);
    GAS unsigned char* HX = (GAS unsigned char*)(F.ws + WS_HX);
    const int d0 = F.lane * 16;
    for (int row = F.bid * 8 + F.wave; row < NTOK; row += F.G * 8) {
        const GAS float* m = MOD + (size_t)mod_row(row) * 6144;
        float x[16], sh[16], sc[16], f[16];
        ld16_f32(xrow_ptr(F, A, 0, row) + d0, x); ld16_f32(m + d0, sh); ld16_f32(m + 1024 + d0, sc);
#pragma unroll
        for (int q = 0; q < 16; ++q) f[q] = x[q] * (1.f + sc[q]) + sh[q];
        *(GAS u32x4*)(HX + (size_t)row * 1024 + d0) = pack16_fp8(f);
    }
}

__device__ __forceinline__ int gla_row(int b, int h, int n, int j) {
    const int m = n - 4;
    const int base_ctx = b * 256 + n * 64, base_row = NCTX + b * 8192 + m * 64, base_col = NCTX + b * 8192 + (m & 1) * 4096 + (m >> 1);
    const bool ctx = n < 4, col = (!ctx) && (h >= 2);
    const int base = ctx ? base_ctx : (col ? base_col : base_row);
    const int stride = col ? 64 : 1;
    return base + j * stride;
}
constexpr int GL_PA = 0;
constexpr int GL_WUP = 8704;
constexpr int GL_BIA = GL_WUP + 8192;
constexpr int GL_KT = GL_BIA + 512;
constexpr int GL_QD = GL_KT + 2 * 64 * 72 * 2;
constexpr int GL_VT = GL_QD + 2 * 64 * 72 * 2;
constexpr int GL_ATT = GL_VT + 128 * 72 * 2;
constexpr int GL_SSQ = GL_ATT + 64 * 72 * 2;
constexpr int GL_OT = GL_SSQ + 2048;
constexpr int GL_KVT = GL_ATT;
constexpr int GL_KS = 110592;
constexpr int GL_QS = GL_KS + 64 * 72 * 2;
static_assert(GL_OT + 64 * 136 * 2 <= GL_KS && GL_KVT + 2 * 128 * 72 * 2 <= GL_KS && GL_QS + 64 * 72 * 2 <= 131072, "gla lds");

#define LDS_BARRIER() do { asm volatile("s_waitcnt lgkmcnt(0)" ::: "memory"); __builtin_amdgcn_s_barrier(); asm volatile("" ::: "memory"); } while (0)
template <int CTRL, int ROWMASK> __device__ __forceinline__ float dpp_zero(float x) {
    return __builtin_bit_cast(float, __builtin_amdgcn_update_dpp(0, __builtin_bit_cast(int, x), CTRL, ROWMASK, 0xf, true));
}
__device__ __forceinline__ float wave_incl_scan(float x) {
    x += dpp_zero<0x111, 0xf>(x);
    x += dpp_zero<0x112, 0xf>(x);
    x += dpp_zero<0x114, 0xf>(x);
    x += dpp_zero<0x118, 0xf>(x);
    x += dpp_zero<0x142, 0xa>(x);
    x += dpp_zero<0x143, 0xc>(x);
    return x;
}
__device__ __forceinline__ float lane63(float x) { return __builtin_bit_cast(float, __builtin_amdgcn_readlane(__builtin_bit_cast(int, x), 63)); }

template <bool FULL> struct GlaPre {
    u32x4 k, v0, v1;
    u32x4 pa;
    u32x4 q; u32x4 g0, g1; bf16x8 sf0, sf1, sb0, sb1; u32x4 laf, lab;
};
__device__ __forceinline__ int chain_pos(int n, int d) { return d == 0 ? n : (n < 4 ? 3 - n : 135 - n); }
__device__ __forceinline__ size_t la_index(int task, int d, int wave, int lane) { return (((size_t)(task * 2 + d) * 8 + wave) * 64 + lane) * 8; }
template <bool FULL>
__device__ __forceinline__ void gla_prefetch(GlaPre<FULL>& P, const Frame& F, int b, int h, int n, const GAS bf16_t* PX, const GAS bf16_t* SS) {
    const int t = F.tid, bh = b * 4 + h;
    const GAS bf16_t* pr = PX + (size_t)gla_row(b, h, n, t >> 3) * INCP;
    P.k = *(const GAS u32x4*)(pr + C_K + h * 64 + (t & 7) * 8);
    P.v0 = *(const GAS u32x4*)(pr + C_V + h * 128 + (t & 7) * 16);
    P.v1 = *(const GAS u32x4*)(pr + C_V + h * 128 + (t & 7) * 16 + 8);
    if (!FULL) { P.pa = *(const GAS u32x4*)(PX + (size_t)gla_row(b, h, n, (t >> 2) & 63) * INCP + C_DF + 8 * (t & 3)); }
    if (FULL) {
        P.q = *(const GAS u32x4*)(pr + C_Q + h * 64 + (t & 7) * 8);
        { const int i0 = t >> 4, vg = (t & 15) * 8;
          P.g0 = *(const GAS u32x4*)(PX + (size_t)gla_row(b, h, n, i0) * INCP + C_G + h * 128 + vg);
          P.g1 = *(const GAS u32x4*)(PX + (size_t)gla_row(b, h, n, i0 + 32) * INCP + C_G + h * 128 + vg); }
        const int ln = F.lane & 15, lq = F.lane >> 4, v0 = F.wave * 16;
        const size_t chf = (size_t)(bh * 2 + 0) * NCHUNK + chain_pos(n, 0), chb = (size_t)(bh * 2 + 1) * NCHUNK + chain_pos(n, 1);
        P.sf0 = *(const GAS bf16x8*)(SS + (chf * 128 + v0 + ln) * 64 + lq * 8); P.sf1 = *(const GAS bf16x8*)(SS + (chf * 128 + v0 + ln) * 64 + 32 + lq * 8);
        P.sb0 = *(const GAS bf16x8*)(SS + (chb * 128 + v0 + ln) * 64 + lq * 8); P.sb1 = *(const GAS bf16x8*)(SS + (chb * 128 + v0 + ln) * 64 + 32 + lq * 8);
        const GAS bf16_t* la = (const GAS bf16_t*)(F.ws + WS_LA);
        const int task = bh * NCHUNK + n;
        P.laf = *(const GAS u32x4*)(la + la_index(task, 0, F.wave, F.lane)); P.lab = *(const GAS u32x4*)(la + la_index(task, 1, F.wave, F.lane));
    }
}
template <bool FULL>
__device__ __forceinline__ void gla_stage_tiles(const Frame& F, const GlaPre<FULL>& P) {
    const int t = F.tid, row = t >> 3, pc = t & 7;
    *(LAS u32x4*)(F.lds + GL_KS + (row * 72 + pc * 8) * 2) = P.k;
    if (FULL) *(LAS u32x4*)(F.lds + GL_QS + (row * 72 + pc * 8) * 2) = P.q;
    { LAS bf16_t* vt = (LAS bf16_t*)(F.lds + GL_VT);
      float f[8];
      unpack8(P.v0, f);
#pragma unroll
      for (int i = 0; i < 8; ++i) vt[(pc * 16 + i) * 72 + row] = (bf16_t)(__float_as_uint(f[i]) >> 16);
      unpack8(P.v1, f);
#pragma unroll
      for (int i = 0; i < 8; ++i) vt[(pc * 16 + 8 + i) * 72 + row] = (bf16_t)(__float_as_uint(f[i]) >> 16); }
    if (!FULL) { if (t < 256) { const int j = t >> 2, q = t & 3; float f[8]; unpack8(P.pa, f);
        LAS float* p = (LAS float*)(F.lds + GL_PA) + ((q >> 1) * 64 + j) * 17 + (q & 1) * 8;
#pragma unroll
        for (int i = 0; i < 8; ++i) p[i] = f[i]; } }
}
__device__ __forceinline__ void gla_stage_weights(const Frame& F, int l, int h) {
    LAS float* wup = (LAS float*)(F.lds + GL_WUP);
    LAS float* bia = (LAS float*)(F.lds + GL_BIA);
    const int t = F.tid;
    { const int idx = t * 4, d = idx >> 10, r = (idx >> 6) & 15, c = idx & 63;
      const f32x4 w = *(const GAS f32x4*)(inp(F, I_WDU) + ((size_t)(l * 2 + d) * 16 + r) * 256 + h * 64 + c);
      LAS float* p = wup + (d * 16 + r) * 64 + c; p[0] = w[0]; p[1] = w[1]; p[2] = w[2]; p[3] = w[3]; }
    if (t < 128) { const int d = t >> 6, c = t & 63; bia[t] = inp(F, I_BDEC)[(l * 2 + d) * 256 + h * 64 + c]; }
}
template <bool FULL>
__device__ __forceinline__ void gla_decay(const Frame& F, const GlaPre<FULL>& P, int task, float (&bcf)[8], float (&bcb)[8], float (&totf)[8], float (&totb)[8]) {
    LAS float* pa = (LAS float*)(F.lds + GL_PA);
    LAS float* wup = (LAS float*)(F.lds + GL_WUP);
    LAS float* bia = (LAS float*)(F.lds + GL_BIA);
    const int c0 = F.wave * 8, j = F.lane;
#pragma unroll
    for (int d = 0; d < 2; ++d) {
        float la[8];
        if constexpr (FULL) { unpack8(d == 0 ? P.laf : P.lab, la); }
        else {
            float par[16];
#pragma unroll
            for (int r = 0; r < 16; ++r) par[r] = pa[(d * 64 + j) * 17 + r];
            float z[8];
#pragma unroll
            for (int cc = 0; cc < 8; ++cc) z[cc] = bia[d * 64 + c0 + cc];
#pragma unroll
            for (int r = 0; r < 16; ++r) {
                const f32x4 wa = *(const LAS f32x4*)(wup + (d * 16 + r) * 64 + c0), wb = *(const LAS f32x4*)(wup + (d * 16 + r) * 64 + c0 + 4);
#pragma unroll
                for (int cc = 0; cc < 4; ++cc) { z[cc] += par[r] * wa[cc]; z[4 + cc] += par[r] * wb[cc]; }
                if ((r & 3) == 3) asm volatile("" ::: "memory");
            }
#pragma unroll
            for (int cc = 0; cc < 8; ++cc) la[cc] = -__logf(1.0f + __expf(-z[cc])) * 0.0625f;
            const u32x4 w = pack8(la); unpack8(w, la);
            *(GAS u32x4*)((GAS bf16_t*)(F.ws + WS_LA) + la_index(task, d, F.wave, F.lane)) = w;
        }
#pragma unroll
        for (int cc = 0; cc < 8; ++cc) {
            const float p = wave_incl_scan(la[cc]);
            const float tot = lane63(p);
            if (d == 0) { bcf[cc] = p; totf[cc] = tot; } else { bcb[cc] = tot - p + la[cc]; totb[cc] = tot; }
        }
    }
}

__device__ __forceinline__ void phase_c1(const Frame& F0, const Args& A, int l) {
    const Frame F = refresh(F0);
    const GAS bf16_t* PX = (const GAS bf16_t*)(F.ws + WS_PX);
    GAS bf16_t* KV = (GAS bf16_t*)(F.ws + WS_KV);
    GAS float* BL = (GAS float*)(F.ws + WS_BL);
    GAS unsigned char* MIX = (GAS unsigned char*)(F.ws + WS_MIX);
    const int h = F.bid & 3, NQ = NB * NCHUNK;
    gla_stage_weights(F, l, h);
    LDS_BARRIER();
    GlaPre<false> nx;
    if ((F.bid >> 2) < NQ) gla_prefetch<false>(nx, F, (F.bid >> 2) / NCHUNK, h, (F.bid >> 2) % NCHUNK, PX, nullptr);
    for (int q = F.bid >> 2; q < NQ; q += 64) {
        const int b = q / NCHUNK, n = q % NCHUNK, bh = b * 4 + h;
        const GlaPre<false> cu = nx;
        float bcf[8], bcb[8], totf[8], totb[8];
        gla_stage_tiles<false>(F, cu);
        LDS_BARRIER();
        gla_decay<false>(F, cu, bh * NCHUNK + n, bcf, bcb, totf, totb);
        const int j = F.lane, c0 = F.wave * 8;
        {
            float kf[8]; unpack8(*(const LAS u32x4*)(F.lds + GL_KS + (j * 72 + c0) * 2), kf);
            LAS bf16_t* kt = (LAS bf16_t*)(F.lds + GL_KT);
#pragma unroll
            for (int cc = 0; cc < 8; ++cc) {
                kt[(0 * 64 + c0 + cc) * 72 + j] = f2bf(kf[cc] * __expf(totf[cc] - bcf[cc]));
                kt[(1 * 64 + c0 + cc) * 72 + j] = f2bf(kf[cc] * __expf(totb[cc] - bcb[cc]));
            }
            if (j == 0) {
                const int chf = (bh * 2 + 0) * NCHUNK + chain_pos(n, 0), chb = (bh * 2 + 1) * NCHUNK + chain_pos(n, 1);
#pragma unroll
                for (int cc = 0; cc < 8; ++cc) { BL[(size_t)chf * 64 + c0 + cc] = __expf(totf[cc]); BL[(size_t)chb * 64 + c0 + cc] = __expf(totb[cc]); }
            }
        }
        if (q + 64 < NQ) gla_prefetch<false>(nx, F, (q + 64) / NCHUNK, h, (q + 64) % NCHUNK, PX, nullptr);
        LDS_BARRIER();
        {
            const int d = F.wave & 1, vt0 = (F.wave >> 1) * 2;
            const int ln = F.lane & 15, lq = F.lane >> 4;
            LAS bf16_t* kvt = (LAS bf16_t*)(F.lds + GL_KVT);
#pragma unroll
            for (int vi = 0; vi < 2; ++vi) {
                const int v0 = (vt0 + vi) * 16;
                const bf16x8 a0 = *(const LAS bf16x8*)(F.lds + GL_VT + ((v0 + ln) * 72 + lq * 8) * 2);
                const bf16x8 a1 = *(const LAS bf16x8*)(F.lds + GL_VT + ((v0 + ln) * 72 + 32 + lq * 8) * 2);
#pragma unroll
                for (int ct = 0; ct < 4; ++ct) {
                    const bf16x8 b0 = *(const LAS bf16x8*)(F.lds + GL_KT + ((d * 64 + ct * 16 + ln) * 72 + lq * 8) * 2);
                    const bf16x8 b1 = *(const LAS bf16x8*)(F.lds + GL_KT + ((d * 64 + ct * 16 + ln) * 72 + 32 + lq * 8) * 2);
                    f32x4 acc = (f32x4){0.f, 0.f, 0.f, 0.f};
                    acc = __builtin_amdgcn_mfma_f32_16x16x32_bf16(a0, b0, acc, 0, 0, 0);
                    acc = __builtin_amdgcn_mfma_f32_16x16x32_bf16(a1, b1, acc, 0, 0, 0);
#pragma unroll
                    for (int r = 0; r < 4; ++r) kvt[(d * 128 + v0 + lq * 4 + r) * 72 + ct * 16 + ln] = f2bf(acc[r]);
                }
            }
        }
        LDS_BARRIER();
#pragma unroll
        for (int e = 0; e < 4; ++e) { const int item = F.tid + 512 * e, d = item >> 10, v = (item >> 3) & 127, cg = (item & 7) * 8;
            const size_t chain = (size_t)(bh * 2 + d) * NCHUNK + chain_pos(n, d);
            *(GAS u32x4*)(KV + (chain * 128 + v) * 64 + cg) = *(const LAS u32x4*)(F.lds + GL_KVT + ((d * 128 + v) * 72 + cg) * 2); }
    }

    LDS_BARRIER();
    {
        const int ch = (F.tid & 63) * 8;
        const GAS float* wc = inp(F, I_WCONV) + (size_t)l * 3 * 512 + ch;
        float w0[8], w1[8], w2[8];
#pragma unroll
        for (int q = 0; q < 8; ++q) { w0[q] = wc[q]; w1[q] = wc[512 + q]; w2[q] = wc[1024 + q]; }
        const int nblk = (NTOK - row_lo(l)) / 8;
        for (int blk = F.bid * 8 + F.wave; blk < nblk; blk += F.G * 8) {
            const int r0 = row_lo(l) + blk * 8;
            int tseg, seglen;
            if (r0 < NCTX) { tseg = r0 & 255; seglen = 256; } else { tseg = (r0 - NCTX) & 63; seglen = 64; }
            const GAS bf16_t* p = PX + (size_t)r0 * INCP;
            float cg[8], vv[8], um[8], u0[8], up[8];
            if (tseg > 0) { unpack8(*(const GAS u32x4*)(p - INCP + C_CC + ch), cg); unpack8(*(const GAS u32x4*)(p - INCP + C_CV + ch), vv);
#pragma unroll
                for (int q = 0; q < 8; ++q) um[q] = cg[q] * vv[q]; }
            else {
#pragma unroll
                for (int q = 0; q < 8; ++q) um[q] = 0.f; }
            unpack8(*(const GAS u32x4*)(p + C_CC + ch), cg); unpack8(*(const GAS u32x4*)(p + C_CV + ch), vv);
#pragma unroll
            for (int q = 0; q < 8; ++q) u0[q] = cg[q] * vv[q];
#pragma unroll
            for (int i = 0; i < 8; ++i) {
                const GAS bf16_t* pi = p + (size_t)i * INCP;
                if (tseg + i < seglen - 1) { unpack8(*(const GAS u32x4*)(pi + INCP + C_CC + ch), cg); unpack8(*(const GAS u32x4*)(pi + INCP + C_CV + ch), vv);
#pragma unroll
                    for (int q = 0; q < 8; ++q) up[q] = cg[q] * vv[q]; }
                else {
#pragma unroll
                    for (int q = 0; q < 8; ++q) up[q] = 0.f; }
                float bg[8], o[8];
                unpack8(*(const GAS u32x4*)(pi + C_CB + ch), bg);
#pragma unroll
                for (int q = 0; q < 8; ++q) o[q] = bg[q] * (w0[q] * um[q] + w1[q] * u0[q] + w2[q] * up[q]);
#ifdef SKIP_CONV
#pragma unroll
                for (int q = 0; q < 8; ++q) o[q] = 0.f;
#endif
                *(GAS u32x2*)(MIX + (size_t)(r0 + i) * 1024 + ch) = pack8_fp8(o);
#pragma unroll
                for (int q = 0; q < 8; ++q) { um[q] = u0[q]; u0[q] = up[q]; }
            }
        }
    }
}
__device__ __forceinline__ void phase_c2(const Frame& F0) {
    const Frame F = refresh(F0);
    const GAS bf16_t* KV = (const GAS bf16_t*)(F.ws + WS_KV);
    GAS bf16_t* SS = (GAS bf16_t*)(F.ws + WS_SS);
    const GAS float* BL = (const GAS float*)(F.ws + WS_BL);
    const int total = NCHAIN * 128 * 32;
    for (int i = F.bid * 512 + F.tid; i < total; i += F.G * 512) {
        const int chain = i >> 12, rem = i & 4095, v = rem >> 5, c2 = (rem & 31) * 2;
        float s0 = 0.f, s1 = 0.f;
        for (int s = 0; s < NCHUNK; s += 12) {
            unsigned kv[12]; f32x2 a[12];
#pragma unroll
            for (int q = 0; q < 12; ++q) { const size_t cs = (size_t)chain * NCHUNK + s + q;
                kv[q] = *(const GAS unsigned*)(KV + (cs * 128 + v) * 64 + c2); a[q] = *(const GAS f32x2*)(BL + cs * 64 + c2); }
#pragma unroll
            for (int q = 0; q < 12; ++q) { const size_t cs = (size_t)chain * NCHUNK + s + q;
                *(GAS unsigned*)(SS + (cs * 128 + v) * 64 + c2) = cvt_pk_bf16(s0, s1);
                s0 = a[q][0] * s0 + bf_lo(kv[q]); s1 = a[q][1] * s1 + bf_hi(kv[q]); }
        }
    }
}
__device__ __forceinline__ void phase_c3(const Frame& F0, const Args& A, int l) {
    const Frame F = refresh(F0);
    const GAS bf16_t* PX = (const GAS bf16_t*)(F.ws + WS_PX);
    const GAS bf16_t* SS = (const GAS bf16_t*)(F.ws + WS_SS);
    GAS unsigned char* MIX = (GAS unsigned char*)(F.ws + WS_MIX);
    const GAS float* GN = inp(F, I_GN) + (size_t)l * 128;
    const int n0 = (l == DEPTH - 1) ? 4 : 0, nper = NCHUNK - n0, NQ = NB * nper;
    const int h = F.bid & 3;
    LDS_BARRIER();
    GlaPre<true> nx;
    if ((F.bid >> 2) < NQ) gla_prefetch<true>(nx, F, (F.bid >> 2) / nper, h, n0 + (F.bid >> 2) % nper, PX, SS);
    for (int q = F.bid >> 2; q < NQ; q += 64) {
        const int b = q / nper, n = n0 + q % nper, bh = b * 4 + h;
        const GlaPre<true> cu = nx;
        float bcf[8], bcb[8], totf[8], totb[8];
        gla_stage_tiles<true>(F, cu);
        LDS_BARRIER();
        gla_decay<true>(F, cu, bh * NCHUNK + n, bcf, bcb, totf, totb);
        const int j = F.lane, c0 = F.wave * 8;
        {
            float qf[8], kf[8], o[8];
            unpack8(*(const LAS u32x4*)(F.lds + GL_QS + (j * 72 + c0) * 2), qf); unpack8(*(const LAS u32x4*)(F.lds + GL_KS + (j * 72 + c0) * 2), kf);
#pragma unroll
            for (int cc = 0; cc < 8; ++cc) o[cc] = qf[cc] * 0.125f * __expf(bcf[cc]);
            *(LAS u32x4*)(F.lds + GL_QD + ((0 * 64 + j) * 72 + c0) * 2) = pack8(o);
#pragma unroll
            for (int cc = 0; cc < 8; ++cc) o[cc] = qf[cc] * 0.125f * __expf(bcb[cc]);
            *(LAS u32x4*)(F.lds + GL_QD + ((1 * 64 + j) * 72 + c0) * 2) = pack8(o);
#pragma unroll
            for (int cc = 0; cc < 8; ++cc) o[cc] = kf[cc] * __expf(-bcf[cc]);
            *(LAS u32x4*)(F.lds + GL_KT + ((0 * 64 + j) * 72 + c0) * 2) = pack8(o);
#pragma unroll
            for (int cc = 0; cc < 8; ++cc) o[cc] = kf[cc] * __expf(-bcb[cc]);
            *(LAS u32x4*)(F.lds + GL_KT + ((1 * 64 + j) * 72 + c0) * 2) = pack8(o);
        }
        if (q + 64 < NQ) gla_prefetch<true>(nx, F, (q + 64) / nper, h, n0 + (q + 64) % nper, PX, SS);
        LDS_BARRIER();
        const int ln = F.lane & 15, lq = F.lane >> 4;
        {
            LAS bf16_t* att = (LAS bf16_t*)(F.lds + GL_ATT);
#pragma unroll
            for (int tt = 0; tt < 2; ++tt) {
                const int tile = F.wave * 2 + tt, it = tile >> 2, jt = tile & 3;
                f32x4 af = (f32x4){0.f, 0.f, 0.f, 0.f}, ab = af;
#pragma unroll
                for (int ks = 0; ks < 2; ++ks) {
                    const bf16x8 qa = *(const LAS bf16x8*)(F.lds + GL_QD + ((0 * 64 + it * 16 + ln) * 72 + ks * 32 + lq * 8) * 2);
                    const bf16x8 ka = *(const LAS bf16x8*)(F.lds + GL_KT + ((0 * 64 + jt * 16 + ln) * 72 + ks * 32 + lq * 8) * 2);
                    af = __builtin_amdgcn_mfma_f32_16x16x32_bf16(qa, ka, af, 0, 0, 0);
                    const bf16x8 qb = *(const LAS bf16x8*)(F.lds + GL_QD + ((1 * 64 + it * 16 + ln) * 72 + ks * 32 + lq * 8) * 2);
                    const bf16x8 kb = *(const LAS bf16x8*)(F.lds + GL_KT + ((1 * 64 + jt * 16 + ln) * 72 + ks * 32 + lq * 8) * 2);
                    ab = __builtin_amdgcn_mfma_f32_16x16x32_bf16(qb, kb, ab, 0, 0, 0);
                }
                const int jj = jt * 16 + ln;
#pragma unroll
                for (int r = 0; r < 4; ++r) { const int ii = it * 16 + lq * 4 + r;
                    const float v = (jj <= ii ? af[r] : 0.f) + (jj >= ii ? ab[r] : 0.f);
                    att[ii * 72 + jj] = f2bf(v); }
            }
        }
        LDS_BARRIER();
        {
            const int v0 = F.wave * 16;
            bf16x8 bv[2];
#pragma unroll
            for (int ks = 0; ks < 2; ++ks) bv[ks] = *(const LAS bf16x8*)(F.lds + GL_VT + ((v0 + ln) * 72 + ks * 32 + lq * 8) * 2);
            f32x4 acc[4];
#pragma unroll
            for (int it = 0; it < 4; ++it) {
                acc[it] = (f32x4){0.f, 0.f, 0.f, 0.f};
#pragma unroll
                for (int ks = 0; ks < 2; ++ks) {
                    const bf16x8 aa = *(const LAS bf16x8*)(F.lds + GL_ATT + ((it * 16 + ln) * 72 + ks * 32 + lq * 8) * 2);
                    acc[it] = __builtin_amdgcn_mfma_f32_16x16x32_bf16(aa, bv[ks], acc[it], 0, 0, 0);
#ifndef GLA_NO_STATE
                    const bf16x8 qa = *(const LAS bf16x8*)(F.lds + GL_QD + ((0 * 64 + it * 16 + ln) * 72 + ks * 32 + lq * 8) * 2);
                    acc[it] = __builtin_amdgcn_mfma_f32_16x16x32_bf16(qa, ks == 0 ? cu.sf0 : cu.sf1, acc[it], 0, 0, 0);
                    const bf16x8 qb = *(const LAS bf16x8*)(F.lds + GL_QD + ((1 * 64 + it * 16 + ln) * 72 + ks * 32 + lq * 8) * 2);
                    acc[it] = __builtin_amdgcn_mfma_f32_16x16x32_bf16(qb, ks == 0 ? cu.sb0 : cu.sb1, acc[it], 0, 0, 0);
#endif
                }
            }
            LAS float* ssq = (LAS float*)(F.lds + GL_SSQ);
            LAS bf16_t* ot = (LAS bf16_t*)(F.lds + GL_OT);
#pragma unroll
            for (int it = 0; it < 4; ++it)
#pragma unroll
                for (int r = 0; r < 4; ++r) { float s = acc[it][r] * acc[it][r];
                    s = row16_sum(s);
                    if (ln == 0) ssq[F.wave * 64 + it * 16 + lq * 4 + r] = s;
                    ot[(it * 16 + lq * 4 + r) * 136 + v0 + ln] = f2bf(acc[it][r]); }
        }
        LDS_BARRIER();
        {
            LAS float* ssq = (LAS float*)(F.lds + GL_SSQ);
            const int i0 = F.tid >> 4, vg = (F.tid & 15) * 8;
            const f32x4 ga = *(const GAS f32x4*)(GN + vg), gb = *(const GAS f32x4*)(GN + vg + 4);
#pragma unroll
            for (int e = 0; e < 2; ++e) {
                const int ii = i0 + 32 * e;
                float s = 0.f;
#pragma unroll
                for (int w = 0; w < 8; ++w) s += ssq[w * 64 + ii];
                const float rs = rsqrtf(s * (1.0f / 128.0f) + RMS_EPS);
                float o[8], g[8];
                unpack8(*(const LAS u32x4*)(F.lds + GL_OT + (ii * 136 + vg) * 2), o);
                unpack8(e == 0 ? cu.g0 : cu.g1, g);
#pragma unroll
                for (int q = 0; q < 8; ++q) o[q] = o[q] * rs * (q < 4 ? ga[q] : gb[q - 4]) * siluf_(g[q]);
                *(GAS u32x2*)(MIX + (size_t)gla_row(b, h, n, ii) * 1024 + 512 + h * 128 + vg) = pack8_fp8(o);
            }
        }
    }

}
__device__ __forceinline__ void phase_ln1(const Frame& F0, const Args& A, int l) {
    const Frame F = refresh(F0);
    const GAS float* MOD = (const GAS float*)(F.ws + WS_MOD) + (size_t)l * 5 * 6144;
    const GAS bf16_t* YBF = (const GAS bf16_t*)(F.ws + WS_YBF);
    GAS bf16_t* X1 = (GAS bf16_t*)(F.ws + WS_X1); const GAS bf16_t* XSB = (const GAS bf16_t*)(F.ws + WS_XS);
    GAS bf16_t* HX2 = (GAS bf16_t*)(F.ws + WS_HX2); GAS unsigned char* HX2Q = (GAS unsigned char*)(F.ws + WS_HX2Q);
    const int d0 = F.lane * 16;
    float g[16], be[16];
    ld16_f32(inp(F, I_LN1G) + (size_t)l * 1024 + d0, g); ld16_f32(inp(F, I_LN1B) + (size_t)l * 1024 + d0, be);
    LAS float* mc = (LAS float*)(F.lds + 32768);
    { const int voff[3] = {2048, 3072, 4096}; mod_cache_fill<3>(F, mc, MOD, voff); }
    for (int row = row_lo(l) + F.bid * 8 + F.wave; row < NTOK; row += F.G * 8) {
        const LAS float* m = mc + mod_row(row) * 3072;
        float x[16], y[16], gt[16], v[16];
        if (l == 0) ld16_f32(xrow_ptr(F, A, 0, row) + d0, x); else ld16_bf16(XSB + (size_t)row * 1024 + d0, x);
#ifdef SKIP_MIX
#pragma unroll
        for (int q = 0; q < 16; ++q) y[q] = 0.f;
#else
        ld16_bf16(YBF + (size_t)row * 1024 + d0, y);
#endif
        mod_cache_ld(m, F.lane, gt);
        float s = 0.f;
#pragma unroll
        for (int q = 0; q < 16; ++q) { v[q] = ALPHA * x[q] + gt[q] * y[q]; s += v[q]; }
        const float mu = wave_sum(s) * (1.0f / 1024.0f);
        float qv = 0.f;
#pragma unroll
        for (int q = 0; q < 16; ++q) { const float dd = v[q] - mu; qv += dd * dd; }
        const float rstd = rsqrtf(wave_sum(qv) * (1.0f / 1024.0f) + LN_EPS);
        float sc[16], sh[16], o[16], hx[16];
        mod_cache_ld(m + 2048, F.lane, sc); mod_cache_ld(m + 1024, F.lane, sh);
#pragma unroll
        for (int q = 0; q < 16; ++q) { o[q] = (v[q] - mu) * rstd * g[q] + be[q]; hx[q] = o[q] * (1.f + sc[q]) + sh[q]; }
        st_row_bf16(F.lds + F.wave * 4096, F.lane, X1 + (size_t)row * 1024, o);
        st_row_bf16(F.lds + F.wave * 4096, F.lane, HX2 + (size_t)row * 1024, hx);
        *(GAS u32x4*)(HX2Q + (size_t)row * 1024 + d0) = pack16_fp8(hx);
    }
}
__device__ __forceinline__ int rows_per_wg(const Frame& F, int l) { return (NTOK - row_lo(l) + F.G - 1) / F.G; }
template <int CTRL> __device__ __forceinline__ float dpp_f(float x) { return __builtin_bit_cast(float, __builtin_amdgcn_update_dpp(0, __builtin_bit_cast(int, x), CTRL, 0xf, 0xf, true)); }
template <int CTRL> __device__ __forceinline__ unsigned dpp_u(unsigned x) { return (unsigned)__builtin_amdgcn_update_dpp(0, (int)x, CTRL, 0xf, 0xf, true); }
__device__ __forceinline__ unsigned umax_(unsigned a, unsigned b) { return a > b ? a : b; }
__device__ __forceinline__ unsigned fkey(float v) { const unsigned u = __float_as_uint(v); return (u & 0x80000000u) ? ~u : (u | 0x80000000u); }
__device__ __forceinline__ unsigned wave_umax(unsigned k) {
    k = umax_(k, dpp_u<0xB1>(k));
    k = umax_(k, dpp_u<0x4E>(k));
    k = umax_(k, dpp_u<0x141>(k));
    k = umax_(k, dpp_u<0x140>(k));
    const unsigned r0 = __builtin_amdgcn_readlane(k, 0), r1 = __builtin_amdgcn_readlane(k, 16), r2 = __builtin_amdgcn_readlane(k, 32), r3 = __builtin_amdgcn_readlane(k, 48);
    return umax_(umax_(r0, r1), umax_(r2, r3));
}
__device__ __forceinline__ void phase_route(const Frame& F0, const Args& A, int l) {
    const Frame F = refresh(F0);
    const GAS float* LOG = (const GAS float*)(F.ws + WS_LOG);
    GAS int* IDX = (GAS int*)(F.ws + WS_IDX); GAS float* WTS = (GAS float*)(F.ws + WS_WTS); GAS int* HIST = (GAS int*)(F.ws + WS_HIST);
    LAS int* hist = (LAS int*)F.lds;
    __syncthreads();
    if (F.tid < 256) hist[F.tid] = 0;
    __syncthreads();
    const f32x4 bias = *(const GAS f32x4*)(inp(F, I_RB) + (size_t)l * 256 + 4 * F.lane);
    const int rpw = rows_per_wg(F, l), row0 = row_lo(l) + F.bid * rpw;
    const int lane = F.lane, grp = lane >> 3;
    f32x4 lgn = (f32x4){0.f, 0.f, 0.f, 0.f};
    if (F.wave < rpw && row0 + F.wave < NTOK) lgn = *(const GAS f32x4*)(LOG + (size_t)(row0 + F.wave) * 256 + 4 * lane);
    for (int rr = F.wave; rr < rpw; rr += 8) {
        const int row = row0 + rr; if (row >= NTOK) break;
        const f32x4 lg = lgn;
        if (rr + 8 < rpw && row + 8 < NTOK) lgn = *(const GAS f32x4*)(LOG + (size_t)(row + 8) * 256 + 4 * lane);
        const float s0 = sigmoidf_(lg[0]), s1 = sigmoidf_(lg[1]), s2 = sigmoidf_(lg[2]), s3 = sigmoidf_(lg[3]);
        const float v0 = s0 + bias[0], v1 = s1 + bias[1], v2 = s2 + bias[2], v3 = s3 + bias[3];
        float m1 = fmaxf(fmaxf(v0, v1), fmaxf(v2, v3));
        float m2;
        { const float a = fmaxf(v0, v1), b = fminf(v0, v1), c = fmaxf(v2, v3), d = fminf(v2, v3); m2 = fmaxf(fminf(a, c), fmaxf(b, d)); }
        { float o1 = dpp_f<0xB1>(m1), o2 = dpp_f<0xB1>(m2); float n1 = fmaxf(m1, o1), n2 = fmaxf(fminf(m1, o1), fmaxf(m2, o2)); m1 = n1; m2 = n2;
          o1 = dpp_f<0x4E>(m1); o2 = dpp_f<0x4E>(m2); n1 = fmaxf(m1, o1); n2 = fmaxf(fminf(m1, o1), fmaxf(m2, o2)); m1 = n1; m2 = n2;
          o1 = dpp_f<0x141>(m1); o2 = dpp_f<0x141>(m2); n1 = fmaxf(m1, o1); n2 = fmaxf(fminf(m1, o1), fmaxf(m2, o2)); m1 = n1; m2 = n2; }
        const float gs = m1 + m2;
        int cnt = 0;
#pragma unroll
        for (int g2 = 0; g2 < 8; ++g2) { const float sg = __builtin_bit_cast(float, __builtin_amdgcn_readlane(__builtin_bit_cast(int, gs), g2 * 8)); cnt += (sg > gs || (sg == gs && g2 < grp)) ? 1 : 0; }
        const bool sel = cnt < 4;
        unsigned k0 = sel ? ((fkey(v0) & 0xFFFFFF00u) | (unsigned)(255 - 4 * lane)) : 0u;
        unsigned k1 = sel ? ((fkey(v1) & 0xFFFFFF00u) | (unsigned)(254 - 4 * lane)) : 0u;
        unsigned k2 = sel ? ((fkey(v2) & 0xFFFFFF00u) | (unsigned)(253 - 4 * lane)) : 0u;
        unsigned k3 = sel ? ((fkey(v3) & 0xFFFFFF00u) | (unsigned)(252 - 4 * lane)) : 0u;
        int myidx = 0; float mys = 0.f, ssum = 0.f;
#pragma unroll
        for (int k = 0; k < 8; ++k) {
            const unsigned best = wave_umax(umax_(umax_(k0, k1), umax_(k2, k3)));
            const int bi = 255 - (int)(best & 0xFFu);
            const int sub = bi & 3, own = bi >> 2;
            const float ssel = sub == 0 ? s0 : (sub == 1 ? s1 : (sub == 2 ? s2 : s3));
            const float sc = __builtin_bit_cast(float, __builtin_amdgcn_readlane(__builtin_bit_cast(int, ssel), own));
            if (own == lane) { if (sub == 0) k0 = 0u; else if (sub == 1) k1 = 0u; else if (sub == 2) k2 = 0u; else k3 = 0u; }
            ssum += sc;
            if (lane == k) { myidx = bi; mys = sc; }
        }
        if (lane < 8) { IDX[(size_t)row * 8 + lane] = myidx; WTS[(size_t)row * 8 + lane] = mys / ssum * 2.5f; __hip_atomic_fetch_add(&hist[myidx], 1, __ATOMIC_RELAXED, __HIP_MEMORY_SCOPE_WORKGROUP); }
    }
    __syncthreads();
    if (F.tid < 256) HIST[F.bid * 256 + F.tid] = hist[F.tid];
}
__device__ __forceinline__ void phase_slots(const Frame& F0, int l) {
    const Frame F = refresh(F0);
    const GAS int* HIST = (const GAS int*)(F.ws + WS_HIST); const GAS int* IDX = (const GAS int*)(F.ws + WS_IDX);
    GAS int* POS = (GAS int*)(F.ws + WS_POS); GAS int* STOK = (GAS int*)(F.ws + WS_STOK);
    GAS i32x4* MT = (GAS i32x4*)(F.ws + WS_MT); GAS int* NMT = (GAS int*)(F.ws + WS_MT + 1536 * 16);
    LAS int* tot = (LAS int*)F.lds; LAS int* bef = tot + 256; LAS int* pst = bef + 256; LAS int* cur = pst + 256;
    __syncthreads();
    {
        LAS int* part = cur + 256;
        const int e4 = F.lane * 4, g0 = F.wave * 32;
        i32x4 t = (i32x4){0, 0, 0, 0}, bf = (i32x4){0, 0, 0, 0};
#pragma unroll
        for (int b = 0; b < 2; ++b) { i32x4 hv[16];
#pragma unroll
            for (int q = 0; q < 16; ++q) { const int g = g0 + b * 16 + q; hv[q] = (g < F.G) ? *(const GAS i32x4*)(HIST + (size_t)g * 256 + e4) : (i32x4){0, 0, 0, 0}; }
#pragma unroll
            for (int q = 0; q < 16; ++q) { const int g = g0 + b * 16 + q; t += hv[q]; if (g < F.bid) bf += hv[q]; } }
        *(LAS i32x4*)(part + F.wave * 256 + e4) = t; *(LAS i32x4*)(part + 2048 + F.wave * 256 + e4) = bf;
        __syncthreads();
        if (F.tid < 256) { int a = 0, b2 = 0;
#pragma unroll
            for (int w = 0; w < 8; ++w) { a += part[w * 256 + F.tid]; b2 += part[2048 + w * 256 + F.tid]; }
            tot[F.tid] = a; bef[F.tid] = b2; } }
    __syncthreads();
    if (F.tid < 64) {
        const int p0 = (tot[4 * F.tid] + 255) & ~255, p1 = (tot[4 * F.tid + 1] + 255) & ~255, p2 = (tot[4 * F.tid + 2] + 255) & ~255, p3 = (tot[4 * F.tid + 3] + 255) & ~255;
        int s = p0 + p1 + p2 + p3, x = s;
#pragma unroll
        for (int o = 1; o < 64; o <<= 1) { const int y = __shfl_up(x, o); if (F.tid >= o) x += y; }
        const int ex = x - s;
        pst[4 * F.tid] = ex; pst[4 * F.tid + 1] = ex + p0; pst[4 * F.tid + 2] = ex + p0 + p1; pst[4 * F.tid + 3] = ex + p0 + p1 + p2;
    }
    __syncthreads();
    if (F.tid < 256) cur[F.tid] = pst[F.tid] + bef[F.tid];
    __syncthreads();
    const int rpw = rows_per_wg(F, l), row0 = row_lo(l) + F.bid * rpw;
    for (int p = F.tid; p < rpw * 8; p += 512) {
        const int row = row0 + (p >> 3);
        if (row < NTOK) { const int e = IDX[(size_t)row * 8 + (p & 7)]; const int slot = __hip_atomic_fetch_add(&cur[e], 1, __ATOMIC_RELAXED, __HIP_MEMORY_SCOPE_WORKGROUP); STOK[slot] = row; POS[(size_t)row * 8 + (p & 7)] = slot; }
    }
    if (F.bid == 0) {
        if (F.tid < 256) { const int e = F.tid, t = tot[e], ntile = (t + 255) >> 8, t0 = pst[e] >> 8;
            for (int jt = 0; jt < ntile; ++jt) { const int nv = t - jt * 256; MT[t0 + jt] = (i32x4){e, pst[e] + jt * 256, nv < 256 ? nv : 256, 0}; } }
        const int ntr = (pst[255] + ((tot[255] + 255) & ~255)) >> 8;
        const int nsh = (NTOK - row_lo(l)) / 256;
        for (int jt = F.tid; jt < nsh; jt += 512) MT[ntr + jt] = (i32x4){NEXP, SH_BASE + row_lo(l) + jt * 256, 256, 0};
        if (F.tid == 0) *NMT = ntr + nsh;
    }
}
__device__ __forceinline__ void phase_ln2(const Frame& F0, const Args& A, int l) {
    const Frame F = refresh(F0);
    const GAS float* MODL = (const GAS float*)(F.ws + WS_MOD) + (size_t)l * 5 * 6144;
    const GAS float* MODN = (const GAS float*)(F.ws + WS_MOD) + (size_t)1 * 5 * 6144;
    const GAS unsigned char* Y = (const GAS unsigned char*)(F.ws + WS_Y);
    const GAS bf16_t* X1 = (const GAS bf16_t*)(F.ws + WS_X1);
    const GAS int* POS = (const GAS int*)(F.ws + WS_POS); const GAS float* WTS = (const GAS float*)(F.ws + WS_WTS);
    GAS bf16_t* XS = (GAS bf16_t*)(F.ws + WS_XS); GAS unsigned char* HX = (GAS unsigned char*)(F.ws + WS_HX);
    const int d0 = F.lane * 16;
    float g[16], be[16];
    ld16_f32(inp(F, I_LN2G) + (size_t)l * 1024 + d0, g); ld16_f32(inp(F, I_LN2B) + (size_t)l * 1024 + d0, be);
    const int stride = F.G * 8;
    for (int row0 = row_lo(l) + F.bid * 8 + F.wave; row0 < NTOK; row0 += 2 * stride) {
        const int rows[2] = {row0, row0 + stride < NTOK ? row0 + stride : row0};
        u32x4 yv[2][9]; float ww[2][9]; u32x4 xv[2][2];
#pragma unroll
        for (int r = 0; r < 2; ++r) {
            const int row = rows[r];
            const i32x4 p0 = *(const GAS i32x4*)(POS + (size_t)row * 8), p1 = *(const GAS i32x4*)(POS + (size_t)row * 8 + 4);
            const f32x4 w0 = *(const GAS f32x4*)(WTS + (size_t)row * 8), w1 = *(const GAS f32x4*)(WTS + (size_t)row * 8 + 4);
            const int sl[9] = {p0[0], p0[1], p0[2], p0[3], p1[0], p1[1], p1[2], p1[3], SH_BASE + row};
            ww[r][0] = w0[0]; ww[r][1] = w0[1]; ww[r][2] = w0[2]; ww[r][3] = w0[3]; ww[r][4] = w1[0]; ww[r][5] = w1[1]; ww[r][6] = w1[2]; ww[r][7] = w1[3]; ww[r][8] = 1.f;
#pragma unroll
            for (int k = 0; k < 9; ++k) yv[r][k] = __builtin_nontemporal_load((const GAS u32x4*)(Y + (size_t)sl[k] * 1024 + d0));
            xv[r][0] = *(const GAS u32x4*)(X1 + (size_t)row * 1024 + d0); xv[r][1] = *(const GAS u32x4*)(X1 + (size_t)row * 1024 + d0 + 8);
        }
#pragma unroll
        for (int r = 0; r < 2; ++r) {
            const int row = rows[r];
            if (r == 1 && row0 + stride >= NTOK) break;
            const int mr = mod_row(row);
            const GAS float* m = MODL + (size_t)mr * 6144;
            float f[16];
#pragma unroll
            for (int q = 0; q < 16; ++q) f[q] = 0.f;
#ifndef SKIP_MOE
#pragma unroll
            for (int k = 0; k < 9; ++k) { float t[16]; unpack16_fp8(yv[r][k], t);
#pragma unroll
                for (int q = 0; q < 16; ++q) f[q] += ww[r][k] * t[q]; }
#endif
            float x[16], gt[16], v[16];
            { float xa[8], xb[8]; unpack8(xv[r][0], xa); unpack8(xv[r][1], xb);
#pragma unroll
              for (int q = 0; q < 8; ++q) { x[q] = xa[q]; x[8 + q] = xb[q]; } }
            ld16_f32(m + 5120 + d0, gt);
            float s = 0.f;
#pragma unroll
            for (int q = 0; q < 16; ++q) { v[q] = ALPHA * x[q] + gt[q] * f[q]; s += v[q]; }
            const float mu = wave_sum(s) * (1.0f / 1024.0f);
            float qv = 0.f;
#pragma unroll
            for (int q = 0; q < 16; ++q) { const float dd = v[q] - mu; qv += dd * dd; }
            const float rstd = rsqrtf(wave_sum(qv) * (1.0f / 1024.0f) + LN_EPS);
            float o[16];
#pragma unroll
            for (int q = 0; q < 16; ++q) o[q] = (v[q] - mu) * rstd * g[q] + be[q];
            if (l == 0) {
                const GAS float* mn = MODN + (size_t)mr * 6144;
                float sc[16], sh[16], hx[16];
                ld16_f32(mn + 1024 + d0, sc); ld16_f32(mn + d0, sh);
#pragma unroll
                for (int q = 0; q < 16; ++q) hx[q] = o[q] * (1.f + sc[q]) + sh[q];
                st_row_bf16(F.lds + F.wave * 4096, F.lane, XS + (size_t)row * 1024, o);
                *(GAS u32x4*)(HX + (size_t)row * 1024 + d0) = pack16_fp8(hx);
            } else {
                st_row_f32(F.lds + F.wave * 4096, F.lane, ((GAS float*)inp(F, 24)) + (size_t)(row - NCTX) * 1024, o);
            }
        }
    }
}

__device__ __forceinline__ XcdBarrier mkbar(const Frame& F) {
    GAS unsigned char* w = (GAS unsigned char*)inp(F, 25);
    return XcdBarrier{(unsigned*)(w + WS_CTL), xb_xcc_id(), (volatile LAS unsigned*)(F.lds + L_BAR)};
}
constexpr int NPH = 14;
__global__ void __launch_bounds__(512, 2) mk_fwd(Args args) {
    extern __shared__ __attribute__((aligned(16))) unsigned char lds_raw[];
    Frame F;
    F.lds = (LAS unsigned char*)lds_raw; F.ws = args.ws;
    F.tid = threadIdx.x; F.lane = F.tid & 63; F.wave = __builtin_amdgcn_readfirstlane(F.tid >> 6); F.G = gridDim.x; F.bid = blockIdx.x;
    if (F.tid < 24) *(LAS unsigned long long*)(F.lds + L_PTR + F.tid * 8) = (unsigned long long)args.in[F.tid];
    if (F.tid == 24) *(LAS unsigned long long*)(F.lds + L_PTR + 24 * 8) = (unsigned long long)args.out;
    if (F.tid == 25) *(LAS unsigned long long*)(F.lds + L_PTR + 25 * 8) = (unsigned long long)args.ws;
    __syncthreads();
#if MK_N_LAUNCHES == 1
    constexpr int lo = 0, hi = DEPTH * NPH; constexpr bool multi = true;
#else
    const int lo = args.ph_lo, hi = args.ph_hi;
    const bool multi = (hi - lo) > 1;
#endif
    if (multi) {
        if (F.tid == 0) *(LAS u32x4*)(F.lds + L_BAR) = (u32x4){0u, 0u, 0u, 0u};
        __syncthreads();
        (void)xcd_barrier_post((unsigned*)(args.ws + WS_CTL), (volatile LAS unsigned*)(F.lds + L_BAR));
    }
#ifndef PH_MASK
#define PH_MASK 0x3fff
#endif
#define IN(k) (((PH_MASK >> ((k) - pb)) & 1) && lo <= (k) && (k) < hi)
#define MKBAR() mkbar(F)
#define SEAM(k) do { if (IN((k) + 1)) xcd_barrier(MKBAR()); } while (0)
#pragma unroll
    for (int l = 0; l < DEPTH; ++l) {
        const int pb = l * NPH;
#define REPEAT(n, k) for (int rep_ = 0; rep_ < (((REPMASK >> (k)) & 1) ? 2 : 1); ++rep_) { if (rep_) xcd_barrier(MKBAR());
        if (IN(pb + 0)) { if (l == 0) { REPEAT(REPA, 0) phase_weights(F, args, 0); phase_mod(F, args); } SEAM(pb + 0); } }
        if (IN(pb + 1)) { if (l == 0) { REPEAT(REPA, 1) phase_modulate0(F, args); } SEAM(pb + 1); } }
        if (IN(pb + 2)) {
            REPEAT(REPG, 2)
            { const Frame Fr = refresh(F); conv_run(Fr, l, 0, CONV_FRONT); conv_run(Fr, l, CONV_FRONT + CONV_TAIL, 8); __syncthreads(); }
            build_dense_tables(F, NTOK, INCP, 1024);
            pg8::DenseTabOrder S{F.lds, (const char*)(F.ws + WS_HX), (const char*)(F.ws + WS_WIN), 1024, F.ws, F.bid, F.G, l, CONV_FRONT, CONV_TAIL};
            pg8::EpiBf16 E{(bf16_t*)(F.ws + WS_PX), INCP, INC};
            pg8::gemm_phase<pg8::EpiBf16, pg8::DenseTabOrder, true>(F.lds, 512, S, E); }
            SEAM(pb + 2);
        }
        if (IN(pb + 3)) { REPEAT(REPA, 3) phase_c1(F, args, l); } SEAM(pb + 3); }
        if (IN(pb + 4)) { REPEAT(REPA, 4) phase_c2(F); } SEAM(pb + 4); }
        if (IN(pb + 5)) { REPEAT(REPA, 5) phase_c3(F, args, l); } SEAM(pb + 5); }
        if (IN(pb + 6)) {
            REPEAT(REPG, 6)
            build_dense_tables(F, NTOK - row_lo(l), 1024, 1024, row_lo(l) / 256);
            pg8::DenseTabOrder S{F.lds, (const char*)(F.ws + WS_MIX), (const char*)(F.ws + WS_WOUT), 1024, F.ws, 0, 1, 0, 0, 0};
            pg8::EpiBf16 E{(bf16_t*)(F.ws + WS_YBF), 1024, 1024};
            pg8::gemm_phase<pg8::EpiBf16, pg8::DenseTabOrder, true>(F.lds, 512, S, E); }
            SEAM(pb + 6);
        }
        if (IN(pb + 7)) { REPEAT(REPA, 7) phase_ln1(F, args, l); } SEAM(pb + 7); }
        if (IN(pb + 8)) {
            REPEAT(REPG, 8)
            pg8::DenseOrder S; S.init(NTOK - row_lo(l), 256, 1024, (const char*)(F.ws + WS_HX2) + (size_t)row_lo(l) * 2048, (const char*)(F.ws + WS_WR), F.G, F.bid);
            pg8::EpiF32 E{(float*)(F.ws + WS_LOG) + (size_t)row_lo(l) * 256, 256};
            pg8::gemm_phase(F.lds, 1024, S, E); }
            SEAM(pb + 8);
        }
        if (IN(pb + 9)) { REPEAT(REPA, 9) phase_route(F, args, l); } SEAM(pb + 9); }
        if (IN(pb + 10)) { REPEAT(REPA, 10) phase_slots(F, l); } SEAM(pb + 10); }
        if (IN(pb + 11)) {
#define PH11_BODY { build_group_tables<2, true>(F); \
            pg8::Group1Order S{F.lds, (const char*)(F.ws + WS_HX2Q), (const char*)(F.ws + WS_BT1)}; \
            pg8::EpiSwiGLU E{(unsigned char*)(F.ws + WS_H)}; \
            pg8::gemm_phase<pg8::EpiSwiGLU, pg8::Group1Order, true>(F.lds, 512, S, E); }
            PH11_BODY
#if (REPMASK >> 11) & 1
            xcd_barrier(MKBAR()); PH11_BODY
#endif
            SEAM(pb + 11);
        }
        if (IN(pb + 12)) {
#define PH12_BODY { build_group_tables<4, false>(F); \
            pg8::Group2Order S{F.lds, (const char*)(F.ws + WS_H), (const char*)(F.ws + WS_BT2)}; \
            pg8::EpiY E{(unsigned char*)(F.ws + WS_Y)}; \
            pg8::gemm_phase<pg8::EpiY, pg8::Group2Order, true>(F.lds, 128, S, E); }
            PH12_BODY
#if (REPMASK >> 12) & 1
            xcd_barrier(MKBAR()); PH12_BODY
#endif
            SEAM(pb + 12);
        }
        if (IN(pb + 13)) { REPEAT(REPA, 13) phase_ln2(F, args, l); if (l == 0) phase_weights(F, args, 1); } SEAM(pb + 13); }
    }
#undef REPEAT
#undef IN
#undef SEAM
}

extern "C" void kernel_launch(void* const* d_in, const int* in_sizes, int n_in, void* d_out, int out_size, void* d_ws, size_t ws_size, hipStream_t stream) {
    static int grid = 0;
    if (grid == 0) {
        if (n_in != 24 || in_sizes[0] != NLAT * D || out_size != NLAT * D || ws_size < WS_END) {
            fprintf(stderr, "kernel_launch: unexpected problem (n_in %d, in0 %d, out %d, ws %zu, need %zu); nothing launched\n", n_in, n_in > 0 ? in_sizes[0] : -1, out_size, ws_size, (size_t)WS_END);
            grid = -1; return; }
        int dev = 0, cus = 0, per_cu = 0;
        if (hipGetDevice(&dev) != hipSuccess || hipDeviceGetAttribute(&cus, hipDeviceAttributeMultiprocessorCount, dev) != hipSuccess) { fprintf(stderr, "kernel_launch: device query failed\n"); grid = -1; return; }
        if (hipFuncSetAttribute((const void*)mk_fwd, hipFuncAttributeMaxDynamicSharedMemorySize, LDS_BYTES) != hipSuccess) { fprintf(stderr, "kernel_launch: hipFuncSetAttribute failed\n"); grid = -1; return; }
        if (hipOccupancyMaxActiveBlocksPerMultiprocessor(&per_cu, (const void*)mk_fwd, 512, LDS_BYTES) != hipSuccess || per_cu < 1)
            fprintf(stderr, "kernel_launch: note: occupancy query reports %d workgroups per CU\n", per_cu);
        (void)hipGetLastError();
        grid = cus;
        if (grid != 256) fprintf(stderr, "kernel_launch: note: %d CUs (built for 256)\n", grid);
        if (grid > 256) grid = 256;
    }
    if (grid < 0) return;
    if (hipMemsetAsync((char*)d_ws + WS_CTL, 0, 65536, stream) != hipSuccess) { fprintf(stderr, "kernel_launch: memset failed\n"); return; }
    Args a{};
    for (int i = 0; i < 24; ++i) a.in[i] = (const GAS float*)d_in[i];
    a.out = (GAS float*)d_out; a.ws = (GAS unsigned char*)d_ws;
#if MK_N_LAUNCHES == 1
    a.ph_lo = 0; a.ph_hi = DEPTH * NPH;
    hipLaunchKernelGGL(mk_fwd, dim3(grid), dim3(512), LDS_BYTES, stream, a);
#else
    for (int p = 0; p < DEPTH * NPH; ++p) {
        if (p == NPH + 1) continue;
        a.ph_lo = p; a.ph_hi = p + 1;
        hipLaunchKernelGGL(mk_fwd, dim3(grid), dim3(512), LDS_BYTES, stream, a);
    }
#endif
    const hipError_t le = hipPeekAtLastError();
    if (le != hipSuccess) fprintf(stderr, "kernel_launch: launch failed: %s\n", hipGetErrorName(le));
}
```

```cpp
#include <hip/hip_runtime.h>
#include <cstdio>
#include <cstdint>

#ifndef REPMASK
#define REPMASK 0
#endif
#ifndef MK_N_LAUNCHES
#define MK_N_LAUNCHES 1
#endif

#define LAS __attribute__((address_space(3)))
#define GAS __attribute__((address_space(1)))
typedef unsigned short bf16_t;
typedef short bf16x8 __attribute__((ext_vector_type(8)));
typedef float f32x4 __attribute__((ext_vector_type(4)));
typedef float f32x2 __attribute__((ext_vector_type(2)));
typedef unsigned u32x4 __attribute__((ext_vector_type(4)));
typedef unsigned u32x2 __attribute__((ext_vector_type(2)));
typedef int i32x4 __attribute__((ext_vector_type(4)));

constexpr int D = 1024, NB = 4, SEQ = 8192, CTXL = 256, DEPTH = 2;
constexpr int NCTX = NB * CTXL;
constexpr int NLAT = NB * SEQ;
constexpr int NTOK = NCTX + NLAT;
constexpr int INC = 3104, INCP = 3328;
constexpr int C_K = 0, C_V = 256, C_DF = 768, C_DB = 784, C_Q = 800, C_G = 1056, C_CB = 1568, C_CC = 2080, C_CV = 2592;
constexpr int NEXP = 256, TOPK = 8, EH = 256;
constexpr int NCHUNK = 132;
constexpr int NCHAIN = 32;
constexpr int SH_BASE = 335872;
constexpr int NSLOT = SH_BASE + NTOK;
constexpr float ALPHA = 1.41421356237f;
constexpr float LN_EPS = 1e-5f, RMS_EPS = 1e-6f;

constexpr size_t al256(size_t x) { return (x + 255) & ~size_t(255); }
constexpr size_t WS_CTL = 0;
constexpr size_t WS_MOD = 65536;
constexpr size_t WS_WIN = WS_MOD + al256((size_t)2 * 5 * 6144 * 4);
constexpr size_t WS_WOUT = WS_WIN + (size_t)INCP * 1024 * 2;
constexpr size_t WS_WR = WS_WOUT + (size_t)1024 * 1024 * 2;
constexpr size_t WS_BT1 = WS_WR + (size_t)256 * 1024 * 2;
constexpr size_t WS_BT2 = WS_BT1 + (size_t)257 * 512 * 1024 * 2;
constexpr size_t WS_HX = WS_BT2 + (size_t)257 * 1024 * 256 * 2;
constexpr size_t WS_X1 = WS_HX + (size_t)NTOK * 1024 * 2;
constexpr size_t WS_XS = WS_X1 + (size_t)NTOK * 1024 * 4;
constexpr size_t WS_HX2 = WS_XS + (size_t)NTOK * 1024 * 4;
constexpr size_t WS_HX2Q = WS_HX2 + (size_t)NTOK * 1024 * 2;
constexpr size_t WS_LOG = WS_HX2Q + (size_t)NTOK * 1024;
constexpr size_t WS_IDX = WS_LOG + (size_t)NTOK * 256 * 4;
constexpr size_t WS_WTS = WS_IDX + (size_t)NTOK * 8 * 4;
constexpr size_t WS_POS = WS_WTS + (size_t)NTOK * 8 * 4;
constexpr size_t WS_HIST = WS_POS + (size_t)NTOK * 8 * 4;
constexpr size_t WS_STOK = WS_HIST + 262144;
constexpr size_t WS_MT = WS_STOK + (size_t)SH_BASE * 4;
constexpr size_t WS_H = WS_MT + 1536 * 16 + 256;
constexpr size_t WS_ARENA = WS_H + (size_t)NSLOT * 256 * 2;
constexpr size_t WS_PX = WS_ARENA;
constexpr size_t WS_KV = WS_PX + (size_t)NTOK * INCP * 2;
constexpr size_t WS_SS = WS_KV + (size_t)NCHAIN * NCHUNK * 128 * 64 * 2;
constexpr size_t WS_BL = WS_SS + (size_t)NCHAIN * NCHUNK * 128 * 64 * 2;
constexpr size_t WS_MIX = WS_BL + al256((size_t)NCHAIN * NCHUNK * 64 * 4);
constexpr size_t WS_YBF = WS_MIX + (size_t)NTOK * 1024 * 2;
constexpr size_t WS_LA = WS_YBF + (size_t)NTOK * 1024 * 2;
constexpr size_t WS_MIXEND = WS_LA + (size_t)NB * 4 * NCHUNK * 2 * 64 * 64 * 2;
constexpr size_t WS_Y = WS_ARENA;
constexpr size_t WS_END = WS_ARENA + (size_t)NSLOT * 1024 * 2;
static_assert(WS_MIXEND <= WS_END, "arena");
constexpr size_t WS_L1W = WS_BT1 + (size_t)257 * 512 * 1024;
constexpr size_t WS_L1HX = WS_BT2 + (size_t)257 * 1024 * 256;
static_assert(WS_L1W + (WS_BT1 - WS_WIN) <= WS_BT2 && WS_L1HX + (size_t)NTOK * 1024 <= WS_HX, "layer-1 copies");
__host__ __device__ constexpr size_t wl(size_t off, int l) { return l ? WS_L1W + (off - WS_WIN) : off; }
__host__ __device__ constexpr size_t hxl(int l) { return l ? WS_L1HX : WS_HX; }

constexpr int LDS_BYTES = 147456;
constexpr int L_UTAB = 131072;
constexpr int L_NMY = 131072 + 448;
constexpr int L_ROWTAB = 131584;
constexpr int L_BAR = LDS_BYTES - 16;
constexpr int L_PTR = LDS_BYTES - 16 - 256;

#define XB_TMO      128
#define XB_XCNT(j)  (256  + 64 * (j))
#define XB_XSUB(j)  (1280 + 64 * (j))
#define XB_XGEN(j)  (2304 + 64 * (j))
#define XB_TOP      3328
#define XB_TOPGEN   3392
#define XCD_BAR_WORDS 3456
#define XB_SPIN_CAP (1u << 18)

__device__ __forceinline__ unsigned xb_ld(unsigned* p)              { return __hip_atomic_load(p, __ATOMIC_RELAXED, __HIP_MEMORY_SCOPE_AGENT); }
__device__ __forceinline__ unsigned xb_add(unsigned* p, unsigned v) { return __hip_atomic_fetch_add(p, v, __ATOMIC_RELAXED, __HIP_MEMORY_SCOPE_AGENT); }
__device__ __forceinline__ unsigned xb_xcc_id() { return (unsigned)__builtin_amdgcn_s_getreg((3 << 11) | 20) & 0xFu; }
#define XB_SPIN(cond, bar) do { unsigned _sp = 0; while (cond) { __builtin_amdgcn_s_sleep(1); \
    if ((++_sp & 255u) == 0u) { if (xb_ld(&(bar)[XB_TMO])) break; if (_sp > XB_SPIN_CAP) { atomicAdd(&(bar)[XB_TMO], 1u); break; } } } } while (0)

struct XcdBarrier { unsigned* bar; unsigned x; volatile LAS unsigned* st; };

__device__ __forceinline__ XcdBarrier xcd_barrier_post(unsigned* bar, volatile LAS unsigned* st) {
    XcdBarrier b; b.bar = bar; b.x = xb_xcc_id(); b.st = st;
    if (threadIdx.x == 0) (void)xb_add(&bar[XB_XCNT(b.x)], 1u);
    return b;
}
__device__ __forceinline__ void xcd_barrier_complete(unsigned* bar, unsigned x, unsigned& nloc, unsigned& nx) {
    const unsigned G = gridDim.x * gridDim.y * gridDim.z;
    unsigned sum, cnt, mine, sp = 0u;
    for (;;) {
        sum = 0u; cnt = 0u; mine = 0u;
#pragma unroll
        for (unsigned j = 0; j < 16; ++j) { const unsigned c = xb_ld(&bar[XB_XCNT(j)]); sum += c; cnt += (c > 0u) ? 1u : 0u; mine = (j == x) ? c : mine; }
        if (sum == G) break;
        __builtin_amdgcn_s_sleep(1);
        if ((++sp & 255u) == 0u) { if (xb_ld(&bar[XB_TMO])) break; if (sp > XB_SPIN_CAP) { atomicAdd(&bar[XB_TMO], 1u); break; } }
    }
    nloc = mine > 0u ? mine : 1u; nx = cnt > 0u ? cnt : 1u;
}
__device__ __forceinline__ void xcd_barrier(const XcdBarrier& b) {
    asm volatile("s_waitcnt vmcnt(0)" ::: "memory");
    __syncthreads();
    if (threadIdx.x == 0) {
        unsigned* bar = b.bar;
        __builtin_amdgcn_s_waitcnt(0);
        unsigned nloc = b.st[0], nx = b.st[1];
        if (nloc == 0u) { xcd_barrier_complete(bar, b.x, nloc, nx); b.st[0] = nloc; b.st[1] = nx; }
        const unsigned old = xb_add(&bar[XB_XSUB(b.x)], 1u);
        const unsigned gen = old / nloc;
        if (old + 1u == (gen + 1u) * nloc) {
            __builtin_amdgcn_fence(__ATOMIC_RELEASE, "agent");
            asm volatile("s_waitcnt vmcnt(0)" ::: "memory");
            const unsigned og = xb_add(&bar[XB_TOP], 1u);
            const unsigned tg = og / nx;
            if (og + 1u == (tg + 1u) * nx) xb_add(&bar[XB_TOPGEN], 1u);
            else XB_SPIN(xb_ld(&bar[XB_TOPGEN]) == tg, bar);
            __builtin_amdgcn_fence(__ATOMIC_ACQUIRE, "agent");
            xb_add(&bar[XB_XGEN(b.x)], 1u);
            asm volatile("s_waitcnt vmcnt(0)" ::: "memory");
        } else {
            XB_SPIN(xb_ld(&bar[XB_XGEN(b.x)]) == gen, bar);
            __builtin_amdgcn_fence(__ATOMIC_ACQUIRE, "agent");
            asm volatile("s_waitcnt vmcnt(0)" ::: "memory");
        }
    }
    __syncthreads();
}


typedef __bf16 bf16x2_t __attribute__((ext_vector_type(2)));
__device__ __forceinline__ unsigned cvt_pk_bf16(float lo, float hi) { const f32x2 v = (f32x2){lo, hi}; const bf16x2_t b = __builtin_convertvector(v, bf16x2_t); return __builtin_bit_cast(unsigned, b); }
__device__ __forceinline__ bf16_t f2bf(float f) { return (bf16_t)(cvt_pk_bf16(f, 0.f) & 0xffffu); }
__device__ __forceinline__ float bf_lo(unsigned w) { return __uint_as_float(w << 16); }
__device__ __forceinline__ float bf_hi(unsigned w) { return __uint_as_float(w & 0xffff0000u); }
__device__ __forceinline__ float bf2f(bf16_t b) { return __uint_as_float(((unsigned)b) << 16); }
__device__ __forceinline__ float sigmoidf_(float x) { return __builtin_amdgcn_rcpf(1.0f + __expf(-x)); }
__device__ __forceinline__ float siluf_(float x) { return x * __builtin_amdgcn_rcpf(1.0f + __expf(-x)); }
template <int CTRL> __device__ __forceinline__ float dpp_mov_f(float x) { return __builtin_bit_cast(float, __builtin_amdgcn_update_dpp(0, __builtin_bit_cast(int, x), CTRL, 0xf, 0xf, true)); }
__device__ __forceinline__ float row16_sum(float v) {
    v += dpp_mov_f<0xB1>(v);
    v += dpp_mov_f<0x4E>(v);
    v += dpp_mov_f<0x141>(v);
    v += dpp_mov_f<0x140>(v);
    return v;
}
__device__ __forceinline__ float wave_sum(float v) {
    v = row16_sum(v);
    const int b = __builtin_bit_cast(int, v);
    const float r0 = __builtin_bit_cast(float, __builtin_amdgcn_readlane(b, 0)), r1 = __builtin_bit_cast(float, __builtin_amdgcn_readlane(b, 16)),
                r2 = __builtin_bit_cast(float, __builtin_amdgcn_readlane(b, 32)), r3 = __builtin_bit_cast(float, __builtin_amdgcn_readlane(b, 48));
    return (r0 + r1) + (r2 + r3);
}
__device__ __forceinline__ u32x2 pack8_fp8(const float (&f)[8]) {
    int a = 0, b = 0;
    a = __builtin_amdgcn_cvt_pk_fp8_f32(f[0], f[1], a, false); a = __builtin_amdgcn_cvt_pk_fp8_f32(f[2], f[3], a, true);
    b = __builtin_amdgcn_cvt_pk_fp8_f32(f[4], f[5], b, false); b = __builtin_amdgcn_cvt_pk_fp8_f32(f[6], f[7], b, true);
    return (u32x2){(unsigned)a, (unsigned)b};
}
__device__ __forceinline__ void unpack8_fp8(const u32x2 w, float (&f)[8]) {
    const f32x2 a = __builtin_amdgcn_cvt_pk_f32_fp8((int)w.x, false), b = __builtin_amdgcn_cvt_pk_f32_fp8((int)w.x, true), c = __builtin_amdgcn_cvt_pk_f32_fp8((int)w.y, false), d = __builtin_amdgcn_cvt_pk_f32_fp8((int)w.y, true);
    f[0] = a.x; f[1] = a.y; f[2] = b.x; f[3] = b.y; f[4] = c.x; f[5] = c.y; f[6] = d.x; f[7] = d.y;
}
__device__ __forceinline__ void unpack8(const u32x4 w, float (&f)[8]) {
    f[0] = bf_lo(w.x); f[1] = bf_hi(w.x); f[2] = bf_lo(w.y); f[3] = bf_hi(w.y);
    f[4] = bf_lo(w.z); f[5] = bf_hi(w.z); f[6] = bf_lo(w.w); f[7] = bf_hi(w.w);
}
__device__ __forceinline__ u32x4 pack8(const float (&f)[8]) {
    u32x4 w; w.x = cvt_pk_bf16(f[0], f[1]); w.y = cvt_pk_bf16(f[2], f[3]); w.z = cvt_pk_bf16(f[4], f[5]); w.w = cvt_pk_bf16(f[6], f[7]); return w;
}

__device__ __forceinline__ void ld16_f32(const GAS float* p, float (&f)[16]) {
#pragma unroll
    for (int i = 0; i < 4; ++i) { const f32x4 v = *(const GAS f32x4*)(p + 4 * i); f[4 * i] = v[0]; f[4 * i + 1] = v[1]; f[4 * i + 2] = v[2]; f[4 * i + 3] = v[3]; }
}
__device__ __forceinline__ void st16_f32(GAS float* p, const float (&f)[16]) {
#pragma unroll
    for (int i = 0; i < 4; ++i) *(GAS f32x4*)(p + 4 * i) = (f32x4){f[4 * i], f[4 * i + 1], f[4 * i + 2], f[4 * i + 3]};
}
__device__ __forceinline__ void ld16_bf16(const GAS bf16_t* p, float (&f)[16]) {
    float a[8], b[8]; unpack8(*(const GAS u32x4*)p, a); unpack8(*(const GAS u32x4*)(p + 8), b);
#pragma unroll
    for (int i = 0; i < 8; ++i) { f[i] = a[i]; f[8 + i] = b[i]; }
}
__device__ __forceinline__ void st16_bf16(GAS bf16_t* p, const float (&f)[16]) {
    const float a[8] = {f[0], f[1], f[2], f[3], f[4], f[5], f[6], f[7]}, b[8] = {f[8], f[9], f[10], f[11], f[12], f[13], f[14], f[15]};
    *(GAS u32x4*)p = pack8(a); *(GAS u32x4*)(p + 8) = pack8(b);
}
__device__ __forceinline__ void st_row_bf16(LAS unsigned char* scr, int lane, GAS bf16_t* rowp, const float (&f)[16]) {
    const float a[8] = {f[0], f[1], f[2], f[3], f[4], f[5], f[6], f[7]}, b[8] = {f[8], f[9], f[10], f[11], f[12], f[13], f[14], f[15]};
    *(LAS u32x4*)(scr + lane * 32) = pack8(a); *(LAS u32x4*)(scr + lane * 32 + 16) = pack8(b);
    const u32x4 c = *(const LAS u32x4*)(scr + lane * 16), d = *(const LAS u32x4*)(scr + 1024 + lane * 16);
    *(GAS u32x4*)((GAS unsigned char*)rowp + lane * 16) = c; *(GAS u32x4*)((GAS unsigned char*)rowp + 1024 + lane * 16) = d;
}
__device__ __forceinline__ void st_row_f32(LAS unsigned char* scr, int lane, GAS float* rowp, const float (&f)[16]) {
#pragma unroll
    for (int i = 0; i < 4; ++i) *(LAS f32x4*)(scr + lane * 64 + i * 16) = (f32x4){f[4 * i], f[4 * i + 1], f[4 * i + 2], f[4 * i + 3]};
    f32x4 v[4];
#pragma unroll
    for (int i = 0; i < 4; ++i) v[i] = *(const LAS f32x4*)(scr + i * 1024 + lane * 16);
#pragma unroll
    for (int i = 0; i < 4; ++i) *(GAS f32x4*)((GAS unsigned char*)rowp + i * 1024 + lane * 16) = v[i];
}
__device__ __forceinline__ void unpack16_fp8(const u32x4 w, float (&f)[16]) {
    float a[8], b[8]; unpack8_fp8((u32x2){w.x, w.y}, a); unpack8_fp8((u32x2){w.z, w.w}, b);
#pragma unroll
    for (int i = 0; i < 8; ++i) { f[i] = a[i]; f[8 + i] = b[i]; }
}
__device__ __forceinline__ u32x4 pack16_fp8(const float (&f)[16]) {
    const float a[8] = {f[0], f[1], f[2], f[3], f[4], f[5], f[6], f[7]}, b[8] = {f[8], f[9], f[10], f[11], f[12], f[13], f[14], f[15]};
    const u32x2 x = pack8_fp8(a), y = pack8_fp8(b); return (u32x4){x.x, x.y, y.x, y.y};
}
struct Args {
    const GAS float* in[24];
    GAS float* out;
    GAS unsigned char* ws;
    int ph_lo, ph_hi;
};
struct Frame {
    LAS unsigned char* lds;
    GAS unsigned char* ws;
    int tid, lane, wave, G, bid;
};

__device__ __forceinline__ Frame refresh(const Frame& F0) {
    Frame F = F0; int t = threadIdx.x; asm volatile("" : "+v"(t)); F.tid = t; { GAS unsigned char* w = F0.ws; asm volatile("" : "+s"(w)); F.ws = w; } { int b = F0.bid, g = F0.G; asm volatile("" : "+s"(b), "+s"(g)); F.bid = b; F.G = g; } F.lane = t & 63; F.wave = __builtin_amdgcn_readfirstlane(t >> 6); return F;
}
__device__ __forceinline__ const GAS float* inp(const Frame& F, int i) {
    unsigned a = (unsigned)(L_PTR + i * 8); asm volatile("" : "+v"(a));
    const unsigned long long v = *(const LAS unsigned long long*)(F.lds + a);
    const unsigned lo = __builtin_amdgcn_readfirstlane((unsigned)v), hi = __builtin_amdgcn_readfirstlane((unsigned)(v >> 32));
    return (const GAS float*)(((unsigned long long)hi << 32) | lo);
}
enum { I_X = 0, I_C, I_CTX, I_CCTX, I_WMOD, I_BMOD, I_WIN, I_WCONV, I_WDU, I_BDEC, I_GN, I_WOUT, I_LN1G, I_LN1B, I_WR, I_RB,
       I_WEG, I_WEU, I_WED, I_WSG, I_WSU, I_WSD, I_LN2G, I_LN2B };

__device__ __forceinline__ void conv_between(LAS unsigned char* lds, GAS unsigned char* ws, int bid, int G, int l, int k);
namespace pg8 {
constexpr int BM = 256, BK = 64, HALF = 128, HTB = HALF * BK * 2, STAGE_BYTES = 8 * HTB, NXCD = 8, WGM = 8;
__device__ __forceinline__ int lds_byte(int r, int c) { const int st = (r >> 4) * 2 + (c >> 5), rr = r & 15, cc = c & 31, ob = rr * 64 + cc * 2; return st * 1024 + (ob ^ (((ob >> 9) & 1) << 5)); }
__device__ __forceinline__ void stage_rc(int b, int& R, int& C) { const int st = b / 1024, sb = b % 1024, swz = sb ^ (((sb >> 9) & 1) << 5); R = (st >> 1) * 16 + swz / 64; C = (st & 1) * 32 + (swz % 64) / 2; }
__device__ __forceinline__ int perm32(int rho) { const int n = rho >> 4, i = rho & 15; return 8 * (i >> 2) + 4 * n + (i & 3); }

struct Unit { int a0, b0, nv, ix; };
typedef int i32x8 __attribute__((ext_vector_type(8)));
__device__ __forceinline__ i32x8 cat8(const bf16x8 a, const bf16x8 b) { const i32x4 x = __builtin_bit_cast(i32x4, a), y = __builtin_bit_cast(i32x4, b); return __builtin_shufflevector(x, y, 0, 1, 2, 3, 4, 5, 6, 7); }
__device__ __forceinline__ bf16x8 lo8(const i32x8 v) { return __builtin_bit_cast(bf16x8, (i32x4)__builtin_shufflevector(v, v, 0, 1, 2, 3)); }
__device__ __forceinline__ bf16x8 hi8(const i32x8 v) { return __builtin_bit_cast(bf16x8, (i32x4)__builtin_shufflevector(v, v, 4, 5, 6, 7)); }

template <class Epi, class Sched, bool FP8 = false>
__device__ __forceinline__ void gemm_phase(LAS unsigned char* lds, const int K_, const Sched& S, const Epi& E) {
    int tid = threadIdx.x; asm volatile("" : "+v"(tid));
    int K = K_; asm volatile("" : "+s"(K));
    const int wid = __builtin_amdgcn_readfirstlane(tid >> 6), lane = tid & 63, wr = wid >> 2, wc = wid & 3, fr = lane & 15, fq = lane >> 4;
    const int nt = K / BK;
    constexpr bool GATHER = Sched::GATHER;
    unsigned voffA[2], voffB[2], rtoff[2];
#pragma unroll
    for (int i = 0; i < 2; ++i) { int R, C; stage_rc(tid * 16 + i * 8192, R, C); const int Rb = Epi::PERM ? ((R & ~31) + perm32(R & 31)) : R;
        voffA[i] = GATHER ? (unsigned)C * 2u : (unsigned)(R * K + C) * 2u; rtoff[i] = (unsigned)R * 4u; voffB[i] = Sched::BTILED ? (unsigned)(Rb * 128 + C * 2) : (unsigned)(Rb * K + C) * 2u; }
    const size_t kstep = (size_t)(BK * 2);
    const size_t hstep = (size_t)HALF * K * 2;
    const size_t kstepB = Sched::BTILED ? (size_t)32768 : kstep, hstepB = Sched::BTILED ? (size_t)16384 : hstep;
    const unsigned ldsw = (unsigned)wid * 1024u;
    const int aoff = lds_byte(wr * 64 + fr, fq * 8), boff = lds_byte(wc * 32 + fr, fq * 8);
#define PG8_SA(b, h) (((b) * 2 + (h)) * HTB)
#define PG8_SB(b, h) ((4 + (b) * 2 + (h)) * HTB)
#define PG8_STAGE(bufoff, gbase, voff) do { _Pragma("unroll") for (int _i = 0; _i < 2; ++_i) \
        __builtin_amdgcn_global_load_lds((const unsigned*)((const char*)(gbase) + (voff)[_i]), (LAS unsigned*)(lds + (bufoff) + ldsw + _i * 8192), 16, 0, 0); } while (0)
#define PG8_STAGE_A(bufoff, kp, h) do { if constexpr (GATHER) { if ((h) == 0) PG8_STAGE(bufoff, kp, ga0); else PG8_STAGE(bufoff, kp, ga1); } \
        else { PG8_STAGE(bufoff, (kp) + ((h) ? hstep : 0), voffA); } } while (0)
#define PG8_LDA(dst, b, h) do { _Pragma("unroll") for (int m = 0; m < 4; ++m) dst[m] = cat8(*(const LAS bf16x8*)(lds + PG8_SA(b, h) + aoff + m * 2048), *(const LAS bf16x8*)(lds + PG8_SA(b, h) + aoff + m * 2048 + 1024)); } while (0)
#define PG8_LDB(dst, b, h) do { _Pragma("unroll") for (int n = 0; n < 2; ++n) dst[n] = cat8(*(const LAS bf16x8*)(lds + PG8_SB(b, h) + boff + n * 2048), *(const LAS bf16x8*)(lds + PG8_SB(b, h) + boff + n * 2048 + 1024)); } while (0)
#define PG8_MMA(ai, bj, At, Bt) do { __builtin_amdgcn_s_setprio(1); _Pragma("unroll") for (int m = 0; m < 4; ++m) _Pragma("unroll") for (int n = 0; n < 2; ++n) { \
        if constexpr (FP8) { acc[ai][bj][m][n] = __builtin_amdgcn_mfma_scale_f32_16x16x128_f8f6f4(Bt[n], At[m], acc[ai][bj][m][n], 0, 0, 0, 0x7a7a7a7a, 0, 0x7f7f7f7f); } \
        else { acc[ai][bj][m][n] = __builtin_amdgcn_mfma_f32_16x16x32_bf16(lo8(Bt[n]), lo8(At[m]), acc[ai][bj][m][n], 0, 0, 0); \
               acc[ai][bj][m][n] = __builtin_amdgcn_mfma_f32_16x16x32_bf16(hi8(Bt[n]), hi8(At[m]), acc[ai][bj][m][n], 0, 0, 0); } } \
        __builtin_amdgcn_s_setprio(0); } while (0)
#define PG8_WAIT_V(n) asm volatile("s_waitcnt vmcnt(" #n ")" ::: "memory")
#define PG8_WAIT_L(n) asm volatile("s_waitcnt lgkmcnt(" #n ")" ::: "memory")
#define PG8_BAR __builtin_amdgcn_s_barrier()
#define PG8_SCHED __builtin_amdgcn_sched_barrier(0)
    Unit cur, nxt; int ui = 0; bool pexact = false;
    if (!S.next(0, cur)) return;
    f32x4 acc[2][2][4][2];
#pragma unroll
    for (int a = 0; a < 2; ++a)
#pragma unroll
        for (int b = 0; b < 2; ++b)
#pragma unroll
            for (int m = 0; m < 4; ++m)
#pragma unroll
                for (int n = 0; n < 2; ++n) acc[a][b][m][n] = (f32x4){0.f, 0.f, 0.f, 0.f};
    i32x8 At[4], B0[2], B1[2];
    unsigned ga0[2] = {0u, 0u}, ga1[2] = {0u, 0u};
    if constexpr (GATHER) {
#pragma unroll
        for (int i = 0; i < 2; ++i) { ga0[i] = S.arow(cur, rtoff[i]) + voffA[i]; ga1[i] = S.arow(cur, rtoff[i] + HALF * 4) + voffA[i]; }
    }
    const char* cA = S.aptr(cur);
    const char* cB = S.bptr(cur);
    PG8_STAGE(PG8_SB(0, 0), cB, voffB); PG8_STAGE_A(PG8_SA(0, 0), cA, 0); PG8_STAGE(PG8_SB(0, 1), cB + hstepB, voffB); PG8_STAGE_A(PG8_SA(0, 1), cA, 1);
    if (wr == 1) PG8_BAR;
    PG8_WAIT_V(4); PG8_BAR;
    PG8_STAGE(PG8_SB(1, 0), cB + kstepB, voffB); PG8_STAGE_A(PG8_SA(1, 0), cA + kstep, 0); PG8_STAGE(PG8_SB(1, 1), cB + hstepB + kstepB, voffB);
    PG8_WAIT_V(6); PG8_BAR;
    for (;;) {
        const bool has_next = S.next(ui + 1, nxt);
        const char* nA = has_next ? S.aptr(nxt) : cA; const char* nB = has_next ? S.bptr(nxt) : cB;
        const bool do_lo = (wr == 0) || cur.nv > 64, do_hi = cur.nv > 128;
        for (int t = 0; t < nt; t += 2) {
            const bool last = (t == nt - 2);
            const bool pre = Epi::PRE && (t == 0) && (ui > 0);
            const char* a1 = cA + (size_t)(t + 1) * kstep;
            const char* a2 = last ? nA : cA + (size_t)(t + 2) * kstep; const char* b2 = last ? nB : cB + (size_t)(t + 2) * kstepB;
            const char* a3 = a2 + kstep; const char* b3 = b2 + kstepB;
            PG8_LDB(B0, 0, 0); PG8_SCHED; PG8_LDA(At, 0, 0); if (!pre) PG8_STAGE_A(PG8_SA(1, 1), a1, 1);
            PG8_WAIT_L(8); PG8_BAR; PG8_WAIT_L(0); if (do_lo) PG8_MMA(0, 0, At, B0); PG8_BAR; PG8_SCHED;
            if constexpr (GATHER) { if (last && has_next) {
#pragma unroll
                for (int i = 0; i < 2; ++i) { ga0[i] = S.arow(nxt, rtoff[i]) + voffA[i]; ga1[i] = S.arow(nxt, rtoff[i] + HALF * 4) + voffA[i]; } } }
            PG8_LDB(B1, 0, 1); PG8_STAGE(PG8_SB(0, 0), b2, voffB);
            PG8_BAR; PG8_WAIT_L(0); if (do_lo) PG8_MMA(0, 1, At, B1); PG8_BAR;
            if (do_hi) PG8_LDA(At, 0, 1); PG8_STAGE_A(PG8_SA(0, 0), a2, 0);
            PG8_BAR; PG8_WAIT_L(0); if (do_hi) PG8_MMA(1, 0, At, B0); PG8_BAR; PG8_SCHED;
            PG8_STAGE(PG8_SB(0, 1), b2 + hstepB, voffB);
            if (pre && pexact) { if constexpr (Epi::NST == 8) PG8_WAIT_V(14); else if constexpr (Epi::NST == 16) PG8_WAIT_V(22); else if constexpr (Epi::NST == 32) PG8_WAIT_V(38); else PG8_WAIT_V(6); }
            else PG8_WAIT_V(6);
            PG8_BAR; if (do_hi) PG8_MMA(1, 1, At, B1); PG8_BAR;
            PG8_LDB(B0, 1, 0); PG8_SCHED; PG8_LDA(At, 1, 0); PG8_STAGE_A(PG8_SA(0, 1), a2, 1);
            PG8_WAIT_L(8); PG8_BAR; PG8_WAIT_L(0); if (do_lo) PG8_MMA(0, 0, At, B0); PG8_BAR; PG8_SCHED;
            PG8_LDB(B1, 1, 1); PG8_STAGE(PG8_SB(1, 0), b3, voffB);
            PG8_BAR; PG8_WAIT_L(0); if (do_lo) PG8_MMA(0, 1, At, B1); PG8_BAR;
            if (do_hi) PG8_LDA(At, 1, 1); PG8_STAGE_A(PG8_SA(1, 0), a3, 0);
            PG8_BAR; PG8_WAIT_L(0); if (do_hi) PG8_MMA(1, 0, At, B0); PG8_BAR; PG8_SCHED;
            PG8_STAGE(PG8_SB(1, 1), b3 + hstepB, voffB);
            PG8_WAIT_V(6); PG8_BAR; if (do_hi) PG8_MMA(1, 1, At, B1); PG8_BAR;
        }
        if constexpr (Epi::PRE) PG8_STAGE_A(PG8_SA(1, 1), nA + kstep, 1);
        E(acc, cur, wr, wc, fr, fq);
        if constexpr (Epi::PRE) pexact = E.exact(cur);
        S.between(ui);
        if (!has_next) break;
#pragma unroll
        for (int a = 0; a < 2; ++a)
#pragma unroll
            for (int b = 0; b < 2; ++b)
#pragma unroll
                for (int m = 0; m < 4; ++m)
#pragma unroll
                    for (int n = 0; n < 2; ++n) acc[a][b][m][n] = (f32x4){0.f, 0.f, 0.f, 0.f};
        cur = nxt; cA = nA; cB = nB; ++ui;
    }
    PG8_WAIT_V(0);
    if (wr == 0) PG8_BAR;
    PG8_BAR;
#undef PG8_SA
#undef PG8_SB
#undef PG8_STAGE
#undef PG8_STAGE_A
#undef PG8_LDA
#undef PG8_LDB
#undef PG8_MMA
#undef PG8_WAIT_V
#undef PG8_WAIT_L
#undef PG8_BAR
#undef PG8_SCHED
}

struct DenseOrder {
    static constexpr bool GATHER = false, BTILED = false;
    __device__ __forceinline__ void between(int) const {}
    int nM, nN, nwg, G, c, K; const char* A; const char* Bt;
    __device__ void init(int M, int N, int K_, const char* A_, const char* Bt_, int G_, int c_) { nM = M / BM; nN = N / BM; nwg = nM * nN; G = G_; c = c_; K = K_; A = (const char*)A_; Bt = (const char*)Bt_; }
    __device__ __forceinline__ bool next(int i, Unit& u) const {
        const long L = (long)i * G + c; if (L >= nwg) return false;
        int wgid = (int)L; { const int q = nwg / NXCD, r = nwg % NXCD, xcd = wgid % NXCD, off = wgid / NXCD; wgid = (xcd < r ? xcd * (q + 1) : r * (q + 1) + (xcd - r) * q) + off; }
        const int nig = WGM * nN, gid = wgid / nig, fm = gid * WGM, gsz = (nM - fm) < WGM ? (nM - fm) : WGM;
        u.a0 = fm + ((wgid % nig) % gsz); u.b0 = (wgid % nig) / gsz; u.nv = 256; u.ix = 0; return true;
    }
    __device__ __forceinline__ unsigned arow(const Unit&, unsigned) const { return 0u; }
    __device__ __forceinline__ const char* aptr(const Unit& u) const { return A + (size_t)u.a0 * BM * K * 2; }
    __device__ __forceinline__ const char* bptr(const Unit& u) const { return Bt + (size_t)u.b0 * BM * K * 2; }
};

struct Group1Order {
    static constexpr bool GATHER = true, BTILED = true;
    __device__ __forceinline__ void between(int) const {}
    LAS unsigned char* lds; const char* A; const char* Bt;
    __device__ __forceinline__ bool next(int i, Unit& u) const {
        const int n = __builtin_amdgcn_readfirstlane(*(const LAS int*)(lds + L_NMY)); if (i >= n) return false;
        const i32x4 t = *(const LAS i32x4*)(lds + L_UTAB + i * 16);
        const int tx = __builtin_amdgcn_readfirstlane(t.x), ty = __builtin_amdgcn_readfirstlane(t.y), tz = __builtin_amdgcn_readfirstlane(t.z), tw = __builtin_amdgcn_readfirstlane(t.w);
        u.a0 = ty; u.b0 = tx * 2 + tw; u.nv = tz; u.ix = i; return true;
    }
    __device__ __forceinline__ unsigned arow(const Unit& u, unsigned r4) const { return *(const LAS unsigned*)(lds + L_ROWTAB + u.ix * 1024 + r4); }
    __device__ __forceinline__ const char* aptr(const Unit&) const { return A; }
    __device__ __forceinline__ const char* bptr(const Unit& u) const { return Bt + (size_t)u.b0 * 8 * 32768; }
};
struct Group2Order {
    static constexpr bool GATHER = true, BTILED = true;
    __device__ __forceinline__ void between(int) const {}
    LAS unsigned char* lds; const char* A; const char* Bt;
    __device__ __forceinline__ bool next(int i, Unit& u) const {
        const int n = __builtin_amdgcn_readfirstlane(*(const LAS int*)(lds + L_NMY)); if (i >= n) return false;
        const i32x4 t = *(const LAS i32x4*)(lds + L_UTAB + i * 16);
        const int tx = __builtin_amdgcn_readfirstlane(t.x), ty = __builtin_amdgcn_readfirstlane(t.y), tz = __builtin_amdgcn_readfirstlane(t.z), tw = __builtin_amdgcn_readfirstlane(t.w);
        u.a0 = ty; u.b0 = tx * 4 + tw; u.nv = tz; u.ix = tw; return true;
    }
    __device__ __forceinline__ unsigned arow(const Unit& u, unsigned r4) const { return (unsigned)u.a0 * 256u + r4 * 64u; }
    __device__ __forceinline__ const char* aptr(const Unit&) const { return A; }
    __device__ __forceinline__ const char* bptr(const Unit& u) const { return Bt + (size_t)u.b0 * 2 * 32768; }
};
struct DenseTabOrder {
    static constexpr bool GATHER = true, BTILED = true;
    LAS unsigned char* lds; const char* A; const char* Bt; int rowbytes;
    GAS unsigned char* cws; int cbid, cG, clayer, ck0, cn;
    __device__ __forceinline__ void between(int ui) const { if (ui < cn) conv_between(lds, cws, cbid, cG, clayer, ck0 + ui); }
    __device__ __forceinline__ bool next(int i, Unit& u) const {
        const int n = __builtin_amdgcn_readfirstlane(*(const LAS int*)(lds + L_NMY)); if (i >= n) return false;
        const i32x4 t = *(const LAS i32x4*)(lds + L_UTAB + i * 16);
        u.a0 = __builtin_amdgcn_readfirstlane(t.y); u.b0 = __builtin_amdgcn_readfirstlane(t.x); u.nv = 256; u.ix = i; return true;
    }
    __device__ __forceinline__ unsigned arow(const Unit& u, unsigned r4) const { return *(const LAS unsigned*)(lds + L_ROWTAB + u.ix * 1024 + r4); }
    __device__ __forceinline__ const char* aptr(const Unit&) const { return A; }
    __device__ __forceinline__ const char* bptr(const Unit& u) const { return Bt + (size_t)u.b0 * (rowbytes / 128) * 32768; }
};

struct EpiBf16 {
    static constexpr bool PERM = true, PRE = false; static constexpr int NST = 16;
    __device__ __forceinline__ bool exact(const Unit&) const { return true; }
    bf16_t* O; int ldc; int ncol;
    __device__ __forceinline__ void operator()(const f32x4 (&acc)[2][2][4][2], const Unit& u, int, int, int, int) const {
        int tz = threadIdx.x; asm volatile("" : "+v"(tz)); const int wid = tz >> 6, lane = tz & 63, wr = wid >> 2, wc = wid & 3, fr = lane & 15, fq = lane >> 4;
        const int row0 = u.a0 * BM + wr * 64 + fr, col0 = u.b0 * BM + wc * 32 + 8 * fq;
#pragma unroll
        for (int ai = 0; ai < 2; ++ai)
#pragma unroll
            for (int m = 0; m < 4; ++m) { bf16_t* rowp = O + (size_t)(row0 + ai * HALF + m * 16) * ldc + col0;
#pragma unroll
                for (int bj = 0; bj < 2; ++bj) { if (col0 + bj * HALF < ncol) {
                    const f32x4 v0 = acc[ai][bj][m][0], v1 = acc[ai][bj][m][1];
                    u32x4 w; w.x = cvt_pk_bf16(v0[0], v0[1]); w.y = cvt_pk_bf16(v0[2], v0[3]); w.z = cvt_pk_bf16(v1[0], v1[1]); w.w = cvt_pk_bf16(v1[2], v1[3]);
                    *(u32x4*)(rowp + bj * HALF) = w; } } }
    }
};
struct EpiF32 {
    static constexpr bool PERM = false, PRE = false; static constexpr int NST = 32;
    __device__ __forceinline__ bool exact(const Unit&) const { return true; }
    float* C; int ldc;
    __device__ __forceinline__ void operator()(const f32x4 (&acc)[2][2][4][2], const Unit& u, int, int, int, int) const {
        int tz = threadIdx.x; asm volatile("" : "+v"(tz)); const int wid = tz >> 6, lane = tz & 63, wr = wid >> 2, wc = wid & 3, fr = lane & 15, fq = lane >> 4;
        const int row0 = u.a0 * BM + wr * 64 + fr, col0 = u.b0 * BM + wc * 32 + 4 * fq;
#pragma unroll
        for (int ai = 0; ai < 2; ++ai)
#pragma unroll
            for (int m = 0; m < 4; ++m) { float* rowp = C + (size_t)(row0 + ai * HALF + m * 16) * ldc + col0;
#pragma unroll
                for (int bj = 0; bj < 2; ++bj)
#pragma unroll
                    for (int n = 0; n < 2; ++n) *(f32x4*)(rowp + bj * HALF + n * 16) = acc[ai][bj][m][n]; }
    }
};
struct EpiSwiGLU {
    static constexpr bool PERM = true, PRE = true; static constexpr int NST = 8;
    __device__ __forceinline__ bool exact(const Unit&) const { return true; }
    unsigned char* H;
    __device__ __forceinline__ void operator()(const f32x4 (&acc)[2][2][4][2], const Unit& u, int, int, int, int) const {
        int tz = threadIdx.x; asm volatile("" : "+v"(tz)); const int wid = tz >> 6, lane = tz & 63, wr = wid >> 2, wc = wid & 3, fr = lane & 15, fq = lane >> 4;
        const int sub = u.b0 & 1;
        const int col0 = sub * 128 + wc * 32 + 8 * fq;
#pragma unroll
        for (int ai = 0; ai < 2; ++ai)
#pragma unroll
            for (int m = 0; m < 4; ++m) { const int r = ai * HALF + wr * 64 + m * 16 + fr;
                float h[8];
#pragma unroll
                for (int n = 0; n < 2; ++n)
#pragma unroll
                    for (int j = 0; j < 4; ++j) { const float g = acc[ai][0][m][n][j], up = acc[ai][1][m][n][j]; h[n * 4 + j] = siluf_(g) * up; }
                *(u32x2*)(H + (size_t)(u.a0 + r) * 256 + col0) = pack8_fp8(h); }
    }
};
struct EpiY {
    static constexpr bool PERM = true, PRE = true; static constexpr int NST = 8;
    __device__ __forceinline__ bool exact(const Unit& u) const { return u.nv == 256; }
    unsigned char* Y;
    __device__ __forceinline__ void operator()(const f32x4 (&acc)[2][2][4][2], const Unit& u, int, int, int, int) const {
        int tz = threadIdx.x; asm volatile("" : "+v"(tz)); const int wid = tz >> 6, lane = tz & 63, wr = wid >> 2, wc = wid & 3, fr = lane & 15, fq = lane >> 4;
        const int col0 = u.ix * 256 + wc * 64 + 16 * fq;
#pragma unroll
        for (int ai = 0; ai < 2; ++ai)
#pragma unroll
            for (int m = 0; m < 4; ++m) { const int r = ai * HALF + wr * 64 + m * 16 + fr;
                if (r < u.nv) { unsigned char* rowp = Y + (size_t)(u.a0 + r) * 1024 + col0;
                    const f32x4 v0 = acc[ai][0][m][0], v1 = acc[ai][0][m][1], v2 = acc[ai][1][m][0], v3 = acc[ai][1][m][1];
                    const float f[8] = {v0[0], v0[1], v0[2], v0[3], v1[0], v1[1], v1[2], v1[3]}, g[8] = {v2[0], v2[1], v2[2], v2[3], v3[0], v3[1], v3[2], v3[3]};
                    const u32x2 a = pack8_fp8(f), b = pack8_fp8(g);
                    *(u32x4*)rowp = (u32x4){a.x, a.y, b.x, b.y}; } }
    }
};
}

template <int SUB, bool ROWS>
__device__ __forceinline__ void build_group_tables(const Frame& F0) {
    const Frame F = refresh(F0);
    const GAS i32x4* MT = (const GAS i32x4*)(F.ws + WS_MT);
    const int nmt = *(const GAS int*)(F.ws + WS_MT + 1536 * 16);
    const GAS int* STOK = (const GAS int*)(F.ws + WS_STOK);
    const int nwg = nmt * SUB;
    __syncthreads();
    if (F.tid < 24) {
        const long L = (long)F.tid * F.G + F.bid;
        i32x4 e = (i32x4){0, 0, 0, 0};
        if (L < nwg) {
            int wgid = (int)L; { const int q = nwg / 8, r = nwg % 8, xcd = wgid % 8, off = wgid / 8; wgid = (xcd < r ? xcd * (q + 1) : r * (q + 1) + (xcd - r) * q) + off; }
            const i32x4 t = MT[wgid / SUB]; e = (i32x4){t.x, t.y, t.z, wgid % SUB};
        }
        *(LAS i32x4*)(F.lds + L_UTAB + F.tid * 16) = e;
    }
    if (F.tid == 0) *(LAS int*)(F.lds + L_NMY) = nwg > F.bid ? (nwg - F.bid + F.G - 1) / F.G : 0;
    __syncthreads();
    if (ROWS) {
        const int n = *(const LAS int*)(F.lds + L_NMY);
        int tok[8];
#pragma unroll
        for (int j = 0; j < 8; ++j) { const int p = F.tid + 512 * j; tok[j] = 0;
            if (p < n * 256) { const int i = p >> 8, r = p & 255; const i32x4 t = *(const LAS i32x4*)(F.lds + L_UTAB + i * 16);
                if (t.x == NEXP) tok[j] = t.y - SH_BASE + r; else if (r < t.z) tok[j] = STOK[t.y + r]; } }
#pragma unroll
        for (int j = 0; j < 8; ++j) { const int p = F.tid + 512 * j; if (p < n * 256) *(LAS unsigned*)(F.lds + L_ROWTAB + p * 4) = (unsigned)tok[j] * 1024u; }
        __syncthreads();
    }
}

__device__ __forceinline__ void build_dense_tables(const Frame& F0, int M, int N, int rowbytes, int pm0 = 0) {
    const Frame F = refresh(F0);
    pg8::DenseOrder D; D.init(M, N, 0, nullptr, nullptr, F.G, F.bid);
    __syncthreads();
    if (F.tid < 24) { pg8::Unit u; i32x4 e = (i32x4){0, 0, 0, 0}; if (D.next(F.tid, u)) e = (i32x4){u.b0, u.a0 + pm0, 256, 0};
        *(LAS i32x4*)(F.lds + L_UTAB + F.tid * 16) = e; }
    if (F.tid == 0) *(LAS int*)(F.lds + L_NMY) = D.nwg > F.bid ? (D.nwg - F.bid + F.G - 1) / F.G : 0;
    __syncthreads();
    const int n = *(const LAS int*)(F.lds + L_NMY);
    for (int p = F.tid; p < n * 256; p += 512) { const int i = p >> 8, r = p & 255;
        const i32x4 t = *(const LAS i32x4*)(F.lds + L_UTAB + i * 16);
        *(LAS unsigned*)(F.lds + L_ROWTAB + p * 4) = (unsigned)(t.y * 256 + r) * (unsigned)rowbytes; }
    __syncthreads();
}

template <int MAP>
__device__ __forceinline__ void conv_job(const Frame& F, const GAS float* src, int K, int N, int nmat, size_t src_stride, GAS bf16_t* dst, size_t dst_stride, int ldd, int rot) {
    const int nk = K / 64, nn = (N + 255) / 256, per = nk * nn, total = per * nmat;
    for (int t = (F.bid + rot) % F.G; t < total; t += F.G) {
        const int mtx = t / per, r = t % per, kt = r / nn, ntile = r % nn;
        const int k0 = kt * 64 + F.wave * 8, n4 = ntile * 256 + F.lane * 4;
        if (n4 < N) {
            const GAS float* p = src + (size_t)mtx * src_stride + (size_t)k0 * N + n4;
            f32x4 v[8];
#pragma unroll
            for (int i = 0; i < 8; ++i) v[i] = *(const GAS f32x4*)(p + (size_t)i * N);
            GAS bf16_t* dm = dst + (size_t)mtx * dst_stride;
#pragma unroll
            for (int q = 0; q < 4; ++q) {
                const int gn = n4 + q;
                const int row = MAP == 0 ? gn : (MAP == 1 ? ((gn & 127) + 256 * (gn >> 7)) : (128 + (gn & 127) + 256 * (gn >> 7)));
                u32x4 w; w.x = cvt_pk_bf16(v[0][q], v[1][q]); w.y = cvt_pk_bf16(v[2][q], v[3][q]); w.z = cvt_pk_bf16(v[4][q], v[5][q]); w.w = cvt_pk_bf16(v[6][q], v[7][q]);
                *(GAS u32x4*)(dm + (size_t)row * ldd + k0) = w;
            }
        }
    }
}
template <int MAP>
__device__ __forceinline__ void conv_job8(const Frame& F, const GAS float* src, int K, int N, int rows_total, int nmat, size_t src_stride, GAS unsigned char* dst, size_t dst_stride, int rot) {
    const int nk = K / 128, nn = (N + 255) / 256, per = nk * nn, total = per * nmat;
    for (int t = (F.bid + rot) % F.G; t < total; t += F.G) {
        const int mtx = t / per, r = t % per, kt = r / nn, ntile = r % nn;
        const int k0 = kt * 128 + (F.lane >> 3) * 16, n4 = ntile * 256 + F.wave * 32 + (F.lane & 7) * 4;
        f32x4 v[16];
        if (n4 < N) {
            const GAS float* p = src + (size_t)mtx * src_stride + (size_t)k0 * N + n4;
#pragma unroll
            for (int i = 0; i < 16; ++i) v[i] = __builtin_nontemporal_load((const GAS f32x4*)(p + (size_t)i * N));
        } else {
#pragma unroll
            for (int i = 0; i < 16; ++i) v[i] = (f32x4){0.f, 0.f, 0.f, 0.f};
        }
        GAS unsigned char* dm = dst + (size_t)mtx * dst_stride;
#pragma unroll
        for (int q = 0; q < 4; ++q) {
            const int gn = n4 + q;
            const int row = MAP == 0 ? gn : (MAP == 1 ? ((gn & 127) + 256 * (gn >> 7)) : (128 + (gn & 127) + 256 * (gn >> 7)));
            if (row < rows_total) {
                int w[4];
#pragma unroll
                for (int d = 0; d < 4; ++d) { int x = 0;
                    x = __builtin_amdgcn_cvt_pk_fp8_f32(v[4 * d][q] * 32.f, v[4 * d + 1][q] * 32.f, x, false);
                    x = __builtin_amdgcn_cvt_pk_fp8_f32(v[4 * d + 2][q] * 32.f, v[4 * d + 3][q] * 32.f, x, true); w[d] = x; }
                *(GAS u32x4*)(dm + ((size_t)((row >> 8) * nk + kt) * 256 + (row & 255)) * 128 + (F.lane >> 3) * 16) = (u32x4){(unsigned)w[0], (unsigned)w[1], (unsigned)w[2], (unsigned)w[3]};
            }
        }
    }
}
__device__ __forceinline__ void phase_weights(const Frame& F0, const Args& A, int l) {
    const Frame F = refresh(F0);
    conv_job8<0>(F, inp(F, I_WIN) + (size_t)l * 1024 * INC, 1024, INC, INCP, 1, 0, (GAS unsigned char*)(F.ws + wl(WS_WIN, l)), 0, 0);
    conv_job8<0>(F, inp(F, I_WOUT) + (size_t)l * 1024 * 1024, 1024, 1024, 1024, 1, 0, (GAS unsigned char*)(F.ws + wl(WS_WOUT, l)), 0, 104);
    conv_job<0>(F, inp(F, I_WR) + (size_t)l * 1024 * 256, 1024, 256, 1, 0, (GAS bf16_t*)(F.ws + wl(WS_WR, l)), 0, 1024, 136);
}
constexpr int NCONV_ITEMS = 2048 + 2048 + 2048 + 24;
constexpr int CONV_TAIL = 4, CONV_FRONT = 24 - CONV_TAIL;
struct ConvItem { const GAS float* src; GAS unsigned char* dst; int N, map, nk, kt, ntile; };
__device__ __forceinline__ ConvItem conv_item(const Frame& F, int l, int idx) {
    ConvItem c;
    GAS unsigned char* BT1 = (GAS unsigned char*)(F.ws + WS_BT1); GAS unsigned char* BT2 = (GAS unsigned char*)(F.ws + WS_BT2);
    if (idx < 4096) {
        const int up = idx >> 11, j = idx & 2047, e = j >> 3;
        c.src = inp(F, up ? I_WEU : I_WEG) + ((size_t)l * 256 + e) * 1024 * 256; c.dst = BT1 + (size_t)e * 512 * 1024;
        c.N = 256; c.map = 1 + up; c.nk = 8; c.kt = j & 7; c.ntile = 0;
    } else if (idx < 6144) {
        const int j = idx - 4096, e = j >> 3, r = j & 7;
        c.src = inp(F, I_WED) + ((size_t)l * 256 + e) * 256 * 1024; c.dst = BT2 + (size_t)e * 1024 * 256;
        c.N = 1024; c.map = 3; c.nk = 2; c.kt = r >> 2; c.ntile = r & 3;
    } else {
        const int j = idx - 6144, which = j >> 3, r = j & 7;
        if (which < 2) { c.src = inp(F, which ? I_WSU : I_WSG) + (size_t)l * 1024 * 256; c.dst = BT1 + (size_t)256 * 512 * 1024; c.N = 256; c.map = 1 + which; c.nk = 8; c.kt = r; c.ntile = 0; }
        else { c.src = inp(F, I_WSD) + (size_t)l * 256 * 1024; c.dst = BT2 + (size_t)256 * 1024 * 256; c.N = 1024; c.map = 3; c.nk = 2; c.kt = r >> 2; c.ntile = r & 3; }
    }
    return c;
}
struct ConvRegs { f32x4 v[16]; };
__device__ __forceinline__ void conv_issue(const Frame& F, const ConvItem& c, ConvRegs& R) {
    const GAS float* p = c.src + (size_t)(c.kt * 128 + (F.lane >> 3) * 16) * c.N + c.ntile * 256 + F.wave * 32 + (F.lane & 7) * 4;
#pragma unroll
    for (int i = 0; i < 16; ++i) R.v[i] = __builtin_nontemporal_load((const GAS f32x4*)(p + (size_t)i * c.N));
}
__device__ __forceinline__ void conv_finish(const Frame& F, const ConvItem& c, const ConvRegs& R) {
#pragma unroll
    for (int q = 0; q < 4; ++q) {
        const int gn = c.ntile * 256 + F.wave * 32 + (F.lane & 7) * 4 + q;
        int row;
        if (c.map == 0) row = gn;
        else if (c.map == 1) row = (gn & 127) + 256 * (gn >> 7);
        else if (c.map == 2) row = 128 + (gn & 127) + 256 * (gn >> 7);
        else { const int o = gn & 255; row = (gn & ~255) + 128 * ((o >> 3) & 1) + 32 * (o >> 6) + 8 * ((o >> 4) & 3) + (o & 7); }
        int w[4];
#pragma unroll
        for (int d = 0; d < 4; ++d) { int x = 0;
            x = __builtin_amdgcn_cvt_pk_fp8_f32(R.v[4 * d][q] * 32.f, R.v[4 * d + 1][q] * 32.f, x, false);
            x = __builtin_amdgcn_cvt_pk_fp8_f32(R.v[4 * d + 2][q] * 32.f, R.v[4 * d + 3][q] * 32.f, x, true); w[d] = x; }
        *(GAS u32x4*)(c.dst + ((size_t)((row >> 8) * c.nk + c.kt) * 256 + (row & 255)) * 128 + (F.lane >> 3) * 16) = (u32x4){(unsigned)w[0], (unsigned)w[1], (unsigned)w[2], (unsigned)w[3]};
    }
}
__device__ __forceinline__ void conv_run(const Frame& F, int l, int first, int count) {
    for (int k = first; k < first + count; ++k) { const int idx = F.bid + k * F.G; if (idx >= NCONV_ITEMS) break;
        const ConvItem c = conv_item(F, l, idx); ConvRegs R; conv_issue(F, c, R); conv_finish(F, c, R); }
}
__device__ __forceinline__ void conv_between(LAS unsigned char* lds, GAS unsigned char* ws, int bid, int G, int l, int k) {
    const int idx = bid + k * G; if (idx >= NCONV_ITEMS) return;
    Frame F; F.lds = lds; F.ws = ws; F.bid = bid; F.G = G; { int t = threadIdx.x; asm volatile("" : "+v"(t)); F.tid = t; F.lane = t & 63; F.wave = __builtin_amdgcn_readfirstlane(t >> 6); }
    const ConvItem c = conv_item(F, l, idx); ConvRegs R; conv_issue(F, c, R); conv_finish(F, c, R);
}
__device__ __forceinline__ void phase_mod(const Frame& F0, const Args& A) {
    const Frame F = refresh(F0);
    LAS float* sc = (LAS float*)F.lds;
    LAS float* red = sc + 5 * 1024;
    GAS float* MOD = (GAS float*)(F.ws + WS_MOD);
    __syncthreads();
    for (int i = F.tid; i < 5 * 1024; i += 512) { const int r = i >> 10, k = i & 1023; const float v = r < 4 ? inp(F, I_C)[r * 1024 + k] : inp(F, I_CCTX)[k]; sc[i] = siluf_(v); }
    __syncthreads();
    const int col = F.tid & 31, ks = F.tid >> 5;
    for (int task = F.bid; task < 2 * 192; task += F.G) {
        const int l = task / 192, c0 = (task % 192) * 32;
        const GAS float* W = inp(F, I_WMOD) + (size_t)l * 1024 * 6144 + c0 + col;
        float a0 = 0.f, a1 = 0.f, a2 = 0.f, a3 = 0.f, a4 = 0.f;
        for (int kb = ks * 64; kb < ks * 64 + 64; kb += 16) {
            float w[16];
#pragma unroll
            for (int q = 0; q < 16; ++q) w[q] = W[(size_t)(kb + q) * 6144];
#pragma unroll
            for (int q = 0; q < 16; ++q) { const int k = kb + q;
                a0 += sc[k] * w[q]; a1 += sc[1024 + k] * w[q]; a2 += sc[2048 + k] * w[q]; a3 += sc[3072 + k] * w[q]; a4 += sc[4096 + k] * w[q]; } }
        red[(ks * 5 + 0) * 32 + col] = a0; red[(ks * 5 + 1) * 32 + col] = a1; red[(ks * 5 + 2) * 32 + col] = a2; red[(ks * 5 + 3) * 32 + col] = a3; red[(ks * 5 + 4) * 32 + col] = a4;
        __syncthreads();
        if (F.tid < 160) { const int r = F.tid >> 5, c = F.tid & 31; float s = inp(F, I_BMOD)[l * 6144 + c0 + c];
            for (int q = 0; q < 16; ++q) s += red[(q * 5 + r) * 32 + c];
            MOD[((size_t)l * 5 + r) * 6144 + c0 + c] = s; }
        __syncthreads();
    }
}
__device__ __forceinline__ int row_lo(int l) { return l == DEPTH - 1 ? NCTX : 0; }
__device__ __forceinline__ int mod_row(int row) { return row < NCTX ? 4 : ((row - NCTX) >> 13); }
__device__ __forceinline__ const GAS float* xrow_ptr(const Frame& F, const Args& A, int l, int row) {
    if (l == 0) return row < NCTX ? inp(F, I_CTX) + (size_t)row * 1024 : inp(F, I_X) + (size_t)(row - NCTX) * 1024;
    return (const GAS float*)(F.ws + WS_XS) + (size_t)row * 1024;
}
template <int NV>
__device__ __forceinline__ void mod_cache_fill(const Frame& F, LAS float* mc, const GAS float* MODL, const int (&voff)[NV]) {
    __syncthreads();
    for (int idx = F.tid; idx < 5 * NV * 1024; idx += 512) {
        const int rv = idx >> 10, e = idx & 1023, r = rv / NV, v = rv % NV;
        mc[rv * 1024 + ((e >> 2) & 3) * 256 + (e >> 4) * 4 + (e & 3)] = MODL[(size_t)r * 6144 + voff[v] + e];
    }
    __syncthreads();
}
__device__ __forceinline__ void mod_cache_ld(const LAS float* vec, int lane, float (&f)[16]) {
#pragma unroll
    for (int i = 0; i < 4; ++i) { const f32x4 t = *(const LAS f32x4*)(vec + i * 256 + lane * 4); f[4 * i] = t[0]; f[4 * i + 1] = t[1]; f[4 * i + 2] = t[2]; f[4 * i + 3] = t[3]; }
}
__device__ __forceinline__ void phase_modulate0(const Frame& F0, const Args& A) {
    const Frame F = refresh(F0);
    const GAS float* MOD = (const GAS float*)(F.ws + WS_MOD);
    GAS unsigned char* HX = (GAS unsigned char*)(F.ws + WS_HX);
    const int d0 = F.lane * 16;
    for (int row = F.bid * 8 + F.wave; row < NTOK; row += F.G * 8) {
        const GAS float* m = MOD + (size_t)mod_row(row) * 6144;
        float x[16], sh[16], sc[16], f[16];
        ld16_f32(xrow_ptr(F, A, 0, row) + d0, x); ld16_f32(m + d0, sh); ld16_f32(m + 1024 + d0, sc);
#pragma unroll
        for (int q = 0; q < 16; ++q) f[q] = x[q] * (1.f + sc[q]) + sh[q];
        *(GAS u32x4*)(HX + (size_t)row * 1024 + d0) = pack16_fp8(f);
    }
}

__device__ __forceinline__ int gla_row(int b, int h, int n, int j) {
    const int m = n - 4;
    const int base_ctx = b * 256 + n * 64, base_row = NCTX + b * 8192 + m * 64, base_col = NCTX + b * 8192 + (m & 1) * 4096 + (m >> 1);
    const bool ctx = n < 4, col = (!ctx) && (h >= 2);
    const int base = ctx ? base_ctx : (col ? base_col : base_row);
    const int stride = col ? 64 : 1;
    return base + j * stride;
}
constexpr int GL_PA = 0;
constexpr int GL_WUP = 8704;
constexpr int GL_BIA = GL_WUP + 8192;
constexpr int GL_KT = GL_BIA + 512;
constexpr int GL_QD = GL_KT + 2 * 64 * 72 * 2;
constexpr int GL_VT = GL_QD + 2 * 64 * 72 * 2;
constexpr int GL_ATT = GL_VT + 128 * 72 * 2;
constexpr int GL_SSQ = GL_ATT + 64 * 72 * 2;
constexpr int GL_OT = GL_SSQ + 2048;
constexpr int GL_KVT = GL_ATT;
constexpr int GL_KS = 110592;
constexpr int GL_QS = GL_KS + 64 * 72 * 2;
static_assert(GL_OT + 64 * 136 * 2 <= GL_KS && GL_KVT + 2 * 128 * 72 * 2 <= GL_KS && GL_QS + 64 * 72 * 2 <= 131072, "gla lds");

#define LDS_BARRIER() do { asm volatile("s_waitcnt lgkmcnt(0)" ::: "memory"); __builtin_amdgcn_s_barrier(); asm volatile("" ::: "memory"); } while (0)
template <int CTRL, int ROWMASK> __device__ __forceinline__ float dpp_zero(float x) {
    return __builtin_bit_cast(float, __builtin_amdgcn_update_dpp(0, __builtin_bit_cast(int, x), CTRL, ROWMASK, 0xf, true));
}
__device__ __forceinline__ float wave_incl_scan(float x) {
    x += dpp_zero<0x111, 0xf>(x);
    x += dpp_zero<0x112, 0xf>(x);
    x += dpp_zero<0x114, 0xf>(x);
    x += dpp_zero<0x118, 0xf>(x);
    x += dpp_zero<0x142, 0xa>(x);
    x += dpp_zero<0x143, 0xc>(x);
    return x;
}
__device__ __forceinline__ float lane63(float x) { return __builtin_bit_cast(float, __builtin_amdgcn_readlane(__builtin_bit_cast(int, x), 63)); }

template <bool FULL> struct GlaPre {
    u32x4 k, v0, v1;
    u32x4 pa;
    u32x4 q; u32x4 g0, g1; bf16x8 sf0, sf1, sb0, sb1; u32x4 laf, lab;
};
__device__ __forceinline__ int chain_pos(int n, int d) { return d == 0 ? n : (n < 4 ? 3 - n : 135 - n); }
__device__ __forceinline__ size_t la_index(int task, int d, int wave, int lane) { return (((size_t)(task * 2 + d) * 8 + wave) * 64 + lane) * 8; }
template <bool FULL>
__device__ __forceinline__ void gla_prefetch(GlaPre<FULL>& P, const Frame& F, int b, int h, int n, const GAS bf16_t* PX, const GAS bf16_t* SS) {
    const int t = F.tid, bh = b * 4 + h;
    const GAS bf16_t* pr = PX + (size_t)gla_row(b, h, n, t >> 3) * INCP;
    P.k = *(const GAS u32x4*)(pr + C_K + h * 64 + (t & 7) * 8);
    P.v0 = *(const GAS u32x4*)(pr + C_V + h * 128 + (t & 7) * 16);
    P.v1 = *(const GAS u32x4*)(pr + C_V + h * 128 + (t & 7) * 16 + 8);
    if (!FULL) { P.pa = *(const GAS u32x4*)(PX + (size_t)gla_row(b, h, n, (t >> 2) & 63) * INCP + C_DF + 8 * (t & 3)); }
    if (FULL) {
        P.q = *(const GAS u32x4*)(pr + C_Q + h * 64 + (t & 7) * 8);
        { const int i0 = t >> 4, vg = (t & 15) * 8;
          P.g0 = *(const GAS u32x4*)(PX + (size_t)gla_row(b, h, n, i0) * INCP + C_G + h * 128 + vg);
          P.g1 = *(const GAS u32x4*)(PX + (size_t)gla_row(b, h, n, i0 + 32) * INCP + C_G + h * 128 + vg); }
        const int ln = F.lane & 15, lq = F.lane >> 4, v0 = F.wave * 16;
        const size_t chf = (size_t)(bh * 2 + 0) * NCHUNK + chain_pos(n, 0), chb = (size_t)(bh * 2 + 1) * NCHUNK + chain_pos(n, 1);
        P.sf0 = *(const GAS bf16x8*)(SS + (chf * 128 + v0 + ln) * 64 + lq * 8); P.sf1 = *(const GAS bf16x8*)(SS + (chf * 128 + v0 + ln) * 64 + 32 + lq * 8);
        P.sb0 = *(const GAS bf16x8*)(SS + (chb * 128 + v0 + ln) * 64 + lq * 8); P.sb1 = *(const GAS bf16x8*)(SS + (chb * 128 + v0 + ln) * 64 + 32 + lq * 8);
        const GAS bf16_t* la = (const GAS bf16_t*)(F.ws + WS_LA);
        const int task = bh * NCHUNK + n;
        P.laf = *(const GAS u32x4*)(la + la_index(task, 0, F.wave, F.lane)); P.lab = *(const GAS u32x4*)(la + la_index(task, 1, F.wave, F.lane));
    }
}
template <bool FULL>
__device__ __forceinline__ void gla_stage_tiles(const Frame& F, const GlaPre<FULL>& P) {
    const int t = F.tid, row = t >> 3, pc = t & 7;
    *(LAS u32x4*)(F.lds + GL_KS + (row * 72 + pc * 8) * 2) = P.k;
    if (FULL) *(LAS u32x4*)(F.lds + GL_QS + (row * 72 + pc * 8) * 2) = P.q;
    { LAS bf16_t* vt = (LAS bf16_t*)(F.lds + GL_VT);
      float f[8];
      unpack8(P.v0, f);
#pragma unroll
      for (int i = 0; i < 8; ++i) vt[(pc * 16 + i) * 72 + row] = (bf16_t)(__float_as_uint(f[i]) >> 16);
      unpack8(P.v1, f);
#pragma unroll
      for (int i = 0; i < 8; ++i) vt[(pc * 16 + 8 + i) * 72 + row] = (bf16_t)(__float_as_uint(f[i]) >> 16); }
    if (!FULL) { if (t < 256) { const int j = t >> 2, q = t & 3; float f[8]; unpack8(P.pa, f);
        LAS float* p = (LAS float*)(F.lds + GL_PA) + ((q >> 1) * 64 + j) * 17 + (q & 1) * 8;
#pragma unroll
        for (int i = 0; i < 8; ++i) p[i] = f[i]; } }
}
__device__ __forceinline__ void gla_stage_weights(const Frame& F, int l, int h) {
    LAS float* wup = (LAS float*)(F.lds + GL_WUP);
    LAS float* bia = (LAS float*)(F.lds + GL_BIA);
    const int t = F.tid;
    { const int idx = t * 4, d = idx >> 10, r = (idx >> 6) & 15, c = idx & 63;
      const f32x4 w = *(const GAS f32x4*)(inp(F, I_WDU) + ((size_t)(l * 2 + d) * 16 + r) * 256 + h * 64 + c);
      LAS float* p = wup + (d * 16 + r) * 64 + c; p[0] = w[0]; p[1] = w[1]; p[2] = w[2]; p[3] = w[3]; }
    if (t < 128) { const int d = t >> 6, c = t & 63; bia[t] = inp(F, I_BDEC)[(l * 2 + d) * 256 + h * 64 + c]; }
}
template <bool FULL>
__device__ __forceinline__ void gla_decay(const Frame& F, const GlaPre<FULL>& P, int task, float (&bcf)[8], float (&bcb)[8], float (&totf)[8], float (&totb)[8]) {
    LAS float* pa = (LAS float*)(F.lds + GL_PA);
    LAS float* wup = (LAS float*)(F.lds + GL_WUP);
    LAS float* bia = (LAS float*)(F.lds + GL_BIA);
    const int c0 = F.wave * 8, j = F.lane;
#pragma unroll
    for (int d = 0; d < 2; ++d) {
        float la[8];
        if constexpr (FULL) { unpack8(d == 0 ? P.laf : P.lab, la); }
        else {
            float par[16];
#pragma unroll
            for (int r = 0; r < 16; ++r) par[r] = pa[(d * 64 + j) * 17 + r];
            float z[8];
#pragma unroll
            for (int cc = 0; cc < 8; ++cc) z[cc] = bia[d * 64 + c0 + cc];
#pragma unroll
            for (int r = 0; r < 16; ++r) {
                const f32x4 wa = *(const LAS f32x4*)(wup + (d * 16 + r) * 64 + c0), wb = *(const LAS f32x4*)(wup + (d * 16 + r) * 64 + c0 + 4);
#pragma unroll
                for (int cc = 0; cc < 4; ++cc) { z[cc] += par[r] * wa[cc]; z[4 + cc] += par[r] * wb[cc]; }
                if ((r & 3) == 3) asm volatile("" ::: "memory");
            }
#pragma unroll
            for (int cc = 0; cc < 8; ++cc) la[cc] = -__logf(1.0f + __expf(-z[cc])) * 0.0625f;
            const u32x4 w = pack8(la); unpack8(w, la);
            *(GAS u32x4*)((GAS bf16_t*)(F.ws + WS_LA) + la_index(task, d, F.wave, F.lane)) = w;
        }
#pragma unroll
        for (int cc = 0; cc < 8; ++cc) {
            const float p = wave_incl_scan(la[cc]);
            const float tot = lane63(p);
            if (d == 0) { bcf[cc] = p; totf[cc] = tot; } else { bcb[cc] = tot - p + la[cc]; totb[cc] = tot; }
        }
    }
}

__device__ __forceinline__ void phase_c1(const Frame& F0, const Args& A, int l) {
    const Frame F = refresh(F0);
    const GAS bf16_t* PX = (const GAS bf16_t*)(F.ws + WS_PX);
    GAS bf16_t* KV = (GAS bf16_t*)(F.ws + WS_KV);
    GAS float* BL = (GAS float*)(F.ws + WS_BL);
    GAS unsigned char* MIX = (GAS unsigned char*)(F.ws + WS_MIX);
    const int h = F.bid & 3, NQ = NB * NCHUNK;
    gla_stage_weights(F, l, h);
    LDS_BARRIER();
    GlaPre<false> nx;
    if ((F.bid >> 2) < NQ) gla_prefetch<false>(nx, F, (F.bid >> 2) / NCHUNK, h, (F.bid >> 2) % NCHUNK, PX, nullptr);
    for (int q = F.bid >> 2; q < NQ; q += 64) {
        const int b = q / NCHUNK, n = q % NCHUNK, bh = b * 4 + h;
        const GlaPre<false> cu = nx;
        float bcf[8], bcb[8], totf[8], totb[8];
        gla_stage_tiles<false>(F, cu);
        LDS_BARRIER();
        gla_decay<false>(F, cu, bh * NCHUNK + n, bcf, bcb, totf, totb);
        const int j = F.lane, c0 = F.wave * 8;
        {
            float kf[8]; unpack8(*(const LAS u32x4*)(F.lds + GL_KS + (j * 72 + c0) * 2), kf);
            LAS bf16_t* kt = (LAS bf16_t*)(F.lds + GL_KT);
#pragma unroll
            for (int cc = 0; cc < 8; ++cc) {
                kt[(0 * 64 + c0 + cc) * 72 + j] = f2bf(kf[cc] * __expf(totf[cc] - bcf[cc]));
                kt[(1 * 64 + c0 + cc) * 72 + j] = f2bf(kf[cc] * __expf(totb[cc] - bcb[cc]));
            }
            if (j == 0) {
                const int chf = (bh * 2 + 0) * NCHUNK + chain_pos(n, 0), chb = (bh * 2 + 1) * NCHUNK + chain_pos(n, 1);
#pragma unroll
                for (int cc = 0; cc < 8; ++cc) { BL[(size_t)chf * 64 + c0 + cc] = __expf(totf[cc]); BL[(size_t)chb * 64 + c0 + cc] = __expf(totb[cc]); }
            }
        }
        if (q + 64 < NQ) gla_prefetch<false>(nx, F, (q + 64) / NCHUNK, h, (q + 64) % NCHUNK, PX, nullptr);
        LDS_BARRIER();
        {
            const int d = F.wave & 1, vt0 = (F.wave >> 1) * 2;
            const int ln = F.lane & 15, lq = F.lane >> 4;
            LAS bf16_t* kvt = (LAS bf16_t*)(F.lds + GL_KVT);
#pragma unroll
            for (int vi = 0; vi < 2; ++vi) {
                const int v0 = (vt0 + vi) * 16;
                const bf16x8 a0 = *(const LAS bf16x8*)(F.lds + GL_VT + ((v0 + ln) * 72 + lq * 8) * 2);
                const bf16x8 a1 = *(const LAS bf16x8*)(F.lds + GL_VT + ((v0 + ln) * 72 + 32 + lq * 8) * 2);
#pragma unroll
                for (int ct = 0; ct < 4; ++ct) {
                    const bf16x8 b0 = *(const LAS bf16x8*)(F.lds + GL_KT + ((d * 64 + ct * 16 + ln) * 72 + lq * 8) * 2);
                    const bf16x8 b1 = *(const LAS bf16x8*)(F.lds + GL_KT + ((d * 64 + ct * 16 + ln) * 72 + 32 + lq * 8) * 2);
                    f32x4 acc = (f32x4){0.f, 0.f, 0.f, 0.f};
                    acc = __builtin_amdgcn_mfma_f32_16x16x32_bf16(a0, b0, acc, 0, 0, 0);
                    acc = __builtin_amdgcn_mfma_f32_16x16x32_bf16(a1, b1, acc, 0, 0, 0);
#pragma unroll
                    for (int r = 0; r < 4; ++r) kvt[(d * 128 + v0 + lq * 4 + r) * 72 + ct * 16 + ln] = f2bf(acc[r]);
                }
            }
        }
        LDS_BARRIER();
#pragma unroll
        for (int e = 0; e < 4; ++e) { const int item = F.tid + 512 * e, d = item >> 10, v = (item >> 3) & 127, cg = (item & 7) * 8;
            const size_t chain = (size_t)(bh * 2 + d) * NCHUNK + chain_pos(n, d);
            *(GAS u32x4*)(KV + (chain * 128 + v) * 64 + cg) = *(const LAS u32x4*)(F.lds + GL_KVT + ((d * 128 + v) * 72 + cg) * 2); }
    }

    LDS_BARRIER();
    {
        const int ch = (F.tid & 63) * 8;
        const GAS float* wc = inp(F, I_WCONV) + (size_t)l * 3 * 512 + ch;
        float w0[8], w1[8], w2[8];
#pragma unroll
        for (int q = 0; q < 8; ++q) { w0[q] = wc[q]; w1[q] = wc[512 + q]; w2[q] = wc[1024 + q]; }
        const int nblk = (NTOK - row_lo(l)) / 8;
        for (int blk = F.bid * 8 + F.wave; blk < nblk; blk += F.G * 8) {
            const int r0 = row_lo(l) + blk * 8;
            int tseg, seglen;
            if (r0 < NCTX) { tseg = r0 & 255; seglen = 256; } else { tseg = (r0 - NCTX) & 63; seglen = 64; }
            const GAS bf16_t* p = PX + (size_t)r0 * INCP;
            float cg[8], vv[8], um[8], u0[8], up[8];
            if (tseg > 0) { unpack8(*(const GAS u32x4*)(p - INCP + C_CC + ch), cg); unpack8(*(const GAS u32x4*)(p - INCP + C_CV + ch), vv);
#pragma unroll
                for (int q = 0; q < 8; ++q) um[q] = cg[q] * vv[q]; }
            else {
#pragma unroll
                for (int q = 0; q < 8; ++q) um[q] = 0.f; }
            unpack8(*(const GAS u32x4*)(p + C_CC + ch), cg); unpack8(*(const GAS u32x4*)(p + C_CV + ch), vv);
#pragma unroll
            for (int q = 0; q < 8; ++q) u0[q] = cg[q] * vv[q];
#pragma unroll
            for (int i = 0; i < 8; ++i) {
                const GAS bf16_t* pi = p + (size_t)i * INCP;
                if (tseg + i < seglen - 1) { unpack8(*(const GAS u32x4*)(pi + INCP + C_CC + ch), cg); unpack8(*(const GAS u32x4*)(pi + INCP + C_CV + ch), vv);
#pragma unroll
                    for (int q = 0; q < 8; ++q) up[q] = cg[q] * vv[q]; }
                else {
#pragma unroll
                    for (int q = 0; q < 8; ++q) up[q] = 0.f; }
                float bg[8], o[8];
                unpack8(*(const GAS u32x4*)(pi + C_CB + ch), bg);
#pragma unroll
                for (int q = 0; q < 8; ++q) o[q] = bg[q] * (w0[q] * um[q] + w1[q] * u0[q] + w2[q] * up[q]);
#ifdef SKIP_CONV
#pragma unroll
                for (int q = 0; q < 8; ++q) o[q] = 0.f;
#endif
                *(GAS u32x2*)(MIX + (size_t)(r0 + i) * 1024 + ch) = pack8_fp8(o);
#pragma unroll
                for (int q = 0; q < 8; ++q) { um[q] = u0[q]; u0[q] = up[q]; }
            }
        }
    }
}
__device__ __forceinline__ void phase_c2(const Frame& F0) {
    const Frame F = refresh(F0);
    const GAS bf16_t* KV = (const GAS bf16_t*)(F.ws + WS_KV);
    GAS bf16_t* SS = (GAS bf16_t*)(F.ws + WS_SS);
    const GAS float* BL = (const GAS float*)(F.ws + WS_BL);
    const int total = NCHAIN * 128 * 32;
    for (int i = F.bid * 512 + F.tid; i < total; i += F.G * 512) {
        const int chain = i >> 12, rem = i & 4095, v = rem >> 5, c2 = (rem & 31) * 2;
        float s0 = 0.f, s1 = 0.f;
        for (int s = 0; s < NCHUNK; s += 12) {
            unsigned kv[12]; f32x2 a[12];
#pragma unroll
            for (int q = 0; q < 12; ++q) { const size_t cs = (size_t)chain * NCHUNK + s + q;
                kv[q] = *(const GAS unsigned*)(KV + (cs * 128 + v) * 64 + c2); a[q] = *(const GAS f32x2*)(BL + cs * 64 + c2); }
#pragma unroll
            for (int q = 0; q < 12; ++q) { const size_t cs = (size_t)chain * NCHUNK + s + q;
                *(GAS unsigned*)(SS + (cs * 128 + v) * 64 + c2) = cvt_pk_bf16(s0, s1);
                s0 = a[q][0] * s0 + bf_lo(kv[q]); s1 = a[q][1] * s1 + bf_hi(kv[q]); }
        }
    }
}
__device__ __forceinline__ void phase_c3(const Frame& F0, const Args& A, int l) {
    const Frame F = refresh(F0);
    const GAS bf16_t* PX = (const GAS bf16_t*)(F.ws + WS_PX);
    const GAS bf16_t* SS = (const GAS bf16_t*)(F.ws + WS_SS);
    GAS unsigned char* MIX = (GAS unsigned char*)(F.ws + WS_MIX);
    const GAS float* GN = inp(F, I_GN) + (size_t)l * 128;
    const int n0 = (l == DEPTH - 1) ? 4 : 0, nper = NCHUNK - n0, NQ = NB * nper;
    const int h = F.bid & 3;
    LDS_BARRIER();
    GlaPre<true> nx;
    if ((F.bid >> 2) < NQ) gla_prefetch<true>(nx, F, (F.bid >> 2) / nper, h, n0 + (F.bid >> 2) % nper, PX, SS);
    for (int q = F.bid >> 2; q < NQ; q += 64) {
        const int b = q / nper, n = n0 + q % nper, bh = b * 4 + h;
        const GlaPre<true> cu = nx;
        float bcf[8], bcb[8], totf[8], totb[8];
        gla_stage_tiles<true>(F, cu);
        LDS_BARRIER();
        gla_decay<true>(F, cu, bh * NCHUNK + n, bcf, bcb, totf, totb);
        const int j = F.lane, c0 = F.wave * 8;
        {
            float qf[8], kf[8], o[8];
            unpack8(*(const LAS u32x4*)(F.lds + GL_QS + (j * 72 + c0) * 2), qf); unpack8(*(const LAS u32x4*)(F.lds + GL_KS + (j * 72 + c0) * 2), kf);
#pragma unroll
            for (int cc = 0; cc < 8; ++cc) o[cc] = qf[cc] * 0.125f * __expf(bcf[cc]);
            *(LAS u32x4*)(F.lds + GL_QD + ((0 * 64 + j) * 72 + c0) * 2) = pack8(o);
#pragma unroll
            for (int cc = 0; cc < 8; ++cc) o[cc] = qf[cc] * 0.125f * __expf(bcb[cc]);
            *(LAS u32x4*)(F.lds + GL_QD + ((1 * 64 + j) * 72 + c0) * 2) = pack8(o);
#pragma unroll
            for (int cc = 0; cc < 8; ++cc) o[cc] = kf[cc] * __expf(-bcf[cc]);
            *(LAS u32x4*)(F.lds + GL_KT + ((0 * 64 + j) * 72 + c0) * 2) = pack8(o);
#pragma unroll
            for (int cc = 0; cc < 8; ++cc) o[cc] = kf[cc] * __expf(-bcb[cc]);
            *(LAS u32x4*)(F.lds + GL_KT + ((1 * 64 + j) * 72 + c0) * 2) = pack8(o);
        }
        if (q + 64 < NQ) gla_prefetch<true>(nx, F, (q + 64) / nper, h, n0 + (q + 64) % nper, PX, SS);
        LDS_BARRIER();
        const int ln = F.lane & 15, lq = F.lane >> 4;
        {
            LAS bf16_t* att = (LAS bf16_t*)(F.lds + GL_ATT);
#pragma unroll
            for (int tt = 0; tt < 2; ++tt) {
                const int tile = F.wave * 2 + tt, it = tile >> 2, jt = tile & 3;
                f32x4 af = (f32x4){0.f, 0.f, 0.f, 0.f}, ab = af;
#pragma unroll
                for (int ks = 0; ks < 2; ++ks) {
                    const bf16x8 qa = *(const LAS bf16x8*)(F.lds + GL_QD + ((0 * 64 + it * 16 + ln) * 72 + ks * 32 + lq * 8) * 2);
                    const bf16x8 ka = *(const LAS bf16x8*)(F.lds + GL_KT + ((0 * 64 + jt * 16 + ln) * 72 + ks * 32 + lq * 8) * 2);
                    af = __builtin_amdgcn_mfma_f32_16x16x32_bf16(qa, ka, af, 0, 0, 0);
                    const bf16x8 qb = *(const LAS bf16x8*)(F.lds + GL_QD + ((1 * 64 + it * 16 + ln) * 72 + ks * 32 + lq * 8) * 2);
                    const bf16x8 kb = *(const LAS bf16x8*)(F.lds + GL_KT + ((1 * 64 + jt * 16 + ln) * 72 + ks * 32 + lq * 8) * 2);
                    ab = __builtin_amdgcn_mfma_f32_16x16x32_bf16(qb, kb, ab, 0, 0, 0);
                }
                const int jj = jt * 16 + ln;
#pragma unroll
                for (int r = 0; r < 4; ++r) { const int ii = it * 16 + lq * 4 + r;
                    const float v = (jj <= ii ? af[r] : 0.f) + (jj >= ii ? ab[r] : 0.f);
                    att[ii * 72 + jj] = f2bf(v); }
            }
        }
        LDS_BARRIER();
        {
            const int v0 = F.wave * 16;
            bf16x8 bv[2];
#pragma unroll
            for (int ks = 0; ks < 2; ++ks) bv[ks] = *(const LAS bf16x8*)(F.lds + GL_VT + ((v0 + ln) * 72 + ks * 32 + lq * 8) * 2);
            f32x4 acc[4];
#pragma unroll
            for (int it = 0; it < 4; ++it) {
                acc[it] = (f32x4){0.f, 0.f, 0.f, 0.f};
#pragma unroll
                for (int ks = 0; ks < 2; ++ks) {
                    const bf16x8 aa = *(const LAS bf16x8*)(F.lds + GL_ATT + ((it * 16 + ln) * 72 + ks * 32 + lq * 8) * 2);
                    acc[it] = __builtin_amdgcn_mfma_f32_16x16x32_bf16(aa, bv[ks], acc[it], 0, 0, 0);
#ifndef GLA_NO_STATE
                    const bf16x8 qa = *(const LAS bf16x8*)(F.lds + GL_QD + ((0 * 64 + it * 16 + ln) * 72 + ks * 32 + lq * 8) * 2);
                    acc[it] = __builtin_amdgcn_mfma_f32_16x16x32_bf16(qa, ks == 0 ? cu.sf0 : cu.sf1, acc[it], 0, 0, 0);
                    const bf16x8 qb = *(const LAS bf16x8*)(F.lds + GL_QD + ((1 * 64 + it * 16 + ln) * 72 + ks * 32 + lq * 8) * 2);
                    acc[it] = __builtin_amdgcn_mfma_f32_16x16x32_bf16(qb, ks == 0 ? cu.sb0 : cu.sb1, acc[it], 0, 0, 0);
#endif
                }
            }
            LAS float* ssq = (LAS float*)(F.lds + GL_SSQ);
            LAS bf16_t* ot = (LAS bf16_t*)(F.lds + GL_OT);
#pragma unroll
            for (int it = 0; it < 4; ++it)
#pragma unroll
                for (int r = 0; r < 4; ++r) { float s = acc[it][r] * acc[it][r];
                    s = row16_sum(s);
                    if (ln == 0) ssq[F.wave * 64 + it * 16 + lq * 4 + r] = s;
                    ot[(it * 16 + lq * 4 + r) * 136 + v0 + ln] = f2bf(acc[it][r]); }
        }
        LDS_BARRIER();
        {
            LAS float* ssq = (LAS float*)(F.lds + GL_SSQ);
            const int i0 = F.tid >> 4, vg = (F.tid & 15) * 8;
            const f32x4 ga = *(const GAS f32x4*)(GN + vg), gb = *(const GAS f32x4*)(GN + vg + 4);
#pragma unroll
            for (int e = 0; e < 2; ++e) {
                const int ii = i0 + 32 * e;
                float s = 0.f;
#pragma unroll
                for (int w = 0; w < 8; ++w) s += ssq[w * 64 + ii];
                const float rs = rsqrtf(s * (1.0f / 128.0f) + RMS_EPS);
                float o[8], g[8];
                unpack8(*(const LAS u32x4*)(F.lds + GL_OT + (ii * 136 + vg) * 2), o);
                unpack8(e == 0 ? cu.g0 : cu.g1, g);
#pragma unroll
                for (int q = 0; q < 8; ++q) o[q] = o[q] * rs * (q < 4 ? ga[q] : gb[q - 4]) * siluf_(g[q]);
                *(GAS u32x2*)(MIX + (size_t)gla_row(b, h, n, ii) * 1024 + 512 + h * 128 + vg) = pack8_fp8(o);
            }
        }
    }

}
__device__ __forceinline__ void phase_ln1(const Frame& F0, const Args& A, int l) {
    const Frame F = refresh(F0);
    const GAS float* MOD = (const GAS float*)(F.ws + WS_MOD) + (size_t)l * 5 * 6144;
    const GAS bf16_t* YBF = (const GAS bf16_t*)(F.ws + WS_YBF);
    GAS bf16_t* X1 = (GAS bf16_t*)(F.ws + WS_X1); const GAS bf16_t* XSB = (const GAS bf16_t*)(F.ws + WS_XS);
    GAS bf16_t* HX2 = (GAS bf16_t*)(F.ws + WS_HX2); GAS unsigned char* HX2Q = (GAS unsigned char*)(F.ws + WS_HX2Q);
    const int d0 = F.lane * 16;
    float g[16], be[16];
    ld16_f32(inp(F, I_LN1G) + (size_t)l * 1024 + d0, g); ld16_f32(inp(F, I_LN1B) + (size_t)l * 1024 + d0, be);
    LAS float* mc = (LAS float*)(F.lds + 32768);
    { const int voff[3] = {2048, 3072, 4096}; mod_cache_fill<3>(F, mc, MOD, voff); }
    for (int row = row_lo(l) + F.bid * 8 + F.wave; row < NTOK; row += F.G * 8) {
        const LAS float* m = mc + mod_row(row) * 3072;
        float x[16], y[16], gt[16], v[16];
        if (l == 0) ld16_f32(xrow_ptr(F, A, 0, row) + d0, x); else ld16_bf16(XSB + (size_t)row * 1024 + d0, x);
#ifdef SKIP_MIX
#pragma unroll
        for (int q = 0; q < 16; ++q) y[q] = 0.f;
#else
        ld16_bf16(YBF + (size_t)row * 1024 + d0, y);
#endif
        mod_cache_ld(m, F.lane, gt);
        float s = 0.f;
#pragma unroll
        for (int q = 0; q < 16; ++q) { v[q] = ALPHA * x[q] + gt[q] * y[q]; s += v[q]; }
        const float mu = wave_sum(s) * (1.0f / 1024.0f);
        float qv = 0.f;
#pragma unroll
        for (int q = 0; q < 16; ++q) { const float dd = v[q] - mu; qv += dd * dd; }
        const float rstd = rsqrtf(wave_sum(qv) * (1.0f / 1024.0f) + LN_EPS);
        float sc[16], sh[16], o[16], hx[16];
        mod_cache_ld(m + 2048, F.lane, sc); mod_cache_ld(m + 1024, F.lane, sh);
#pragma unroll
        for (int q = 0; q < 16; ++q) { o[q] = (v[q] - mu) * rstd * g[q] + be[q]; hx[q] = o[q] * (1.f + sc[q]) + sh[q]; }
        st_row_bf16(F.lds + F.wave * 4096, F.lane, X1 + (size_t)row * 1024, o);
        st_row_bf16(F.lds + F.wave * 4096, F.lane, HX2 + (size_t)row * 1024, hx);
        *(GAS u32x4*)(HX2Q + (size_t)row * 1024 + d0) = pack16_fp8(hx);
    }
}
__device__ __forceinline__ int rows_per_wg(const Frame& F, int l) { return (NTOK - row_lo(l) + F.G - 1) / F.G; }
template <int CTRL> __device__ __forceinline__ float dpp_f(float x) { return __builtin_bit_cast(float, __builtin_amdgcn_update_dpp(0, __builtin_bit_cast(int, x), CTRL, 0xf, 0xf, true)); }
template <int CTRL> __device__ __forceinline__ unsigned dpp_u(unsigned x) { return (unsigned)__builtin_amdgcn_update_dpp(0, (int)x, CTRL, 0xf, 0xf, true); }
__device__ __forceinline__ unsigned umax_(unsigned a, unsigned b) { return a > b ? a : b; }
__device__ __forceinline__ unsigned fkey(float v) { const unsigned u = __float_as_uint(v); return (u & 0x80000000u) ? ~u : (u | 0x80000000u); }
__device__ __forceinline__ unsigned wave_umax(unsigned k) {
    k = umax_(k, dpp_u<0xB1>(k));
    k = umax_(k, dpp_u<0x4E>(k));
    k = umax_(k, dpp_u<0x141>(k));
    k = umax_(k, dpp_u<0x140>(k));
    const unsigned r0 = __builtin_amdgcn_readlane(k, 0), r1 = __builtin_amdgcn_readlane(k, 16), r2 = __builtin_amdgcn_readlane(k, 32), r3 = __builtin_amdgcn_readlane(k, 48);
    return umax_(umax_(r0, r1), umax_(r2, r3));
}
__device__ __forceinline__ void phase_route(const Frame& F0, const Args& A, int l) {
    const Frame F = refresh(F0);
    const GAS float* LOG = (const GAS float*)(F.ws + WS_LOG);
    GAS int* IDX = (GAS int*)(F.ws + WS_IDX); GAS float* WTS = (GAS float*)(F.ws + WS_WTS); GAS int* HIST = (GAS int*)(F.ws + WS_HIST);
    LAS int* hist = (LAS int*)F.lds;
    __syncthreads();
    if (F.tid < 256) hist[F.tid] = 0;
    __syncthreads();
    const f32x4 bias = *(const GAS f32x4*)(inp(F, I_RB) + (size_t)l * 256 + 4 * F.lane);
    const int rpw = rows_per_wg(F, l), row0 = row_lo(l) + F.bid * rpw;
    const int lane = F.lane, grp = lane >> 3;
    f32x4 lgn = (f32x4){0.f, 0.f, 0.f, 0.f};
    if (F.wave < rpw && row0 + F.wave < NTOK) lgn = *(const GAS f32x4*)(LOG + (size_t)(row0 + F.wave) * 256 + 4 * lane);
    for (int rr = F.wave; rr < rpw; rr += 8) {
        const int row = row0 + rr; if (row >= NTOK) break;
        const f32x4 lg = lgn;
        if (rr + 8 < rpw && row + 8 < NTOK) lgn = *(const GAS f32x4*)(LOG + (size_t)(row + 8) * 256 + 4 * lane);
        const float s0 = sigmoidf_(lg[0]), s1 = sigmoidf_(lg[1]), s2 = sigmoidf_(lg[2]), s3 = sigmoidf_(lg[3]);
        const float v0 = s0 + bias[0], v1 = s1 + bias[1], v2 = s2 + bias[2], v3 = s3 + bias[3];
        float m1 = fmaxf(fmaxf(v0, v1), fmaxf(v2, v3));
        float m2;
        { const float a = fmaxf(v0, v1), b = fminf(v0, v1), c = fmaxf(v2, v3), d = fminf(v2, v3); m2 = fmaxf(fminf(a, c), fmaxf(b, d)); }
        { float o1 = dpp_f<0xB1>(m1), o2 = dpp_f<0xB1>(m2); float n1 = fmaxf(m1, o1), n2 = fmaxf(fminf(m1, o1), fmaxf(m2, o2)); m1 = n1; m2 = n2;
          o1 = dpp_f<0x4E>(m1); o2 = dpp_f<0x4E>(m2); n1 = fmaxf(m1, o1); n2 = fmaxf(fminf(m1, o1), fmaxf(m2, o2)); m1 = n1; m2 = n2;
          o1 = dpp_f<0x141>(m1); o2 = dpp_f<0x141>(m2); n1 = fmaxf(m1, o1); n2 = fmaxf(fminf(m1, o1), fmaxf(m2, o2)); m1 = n1; m2 = n2; }
        const float gs = m1 + m2;
        int cnt = 0;
#pragma unroll
        for (int g2 = 0; g2 < 8; ++g2) { const float sg = __builtin_bit_cast(float, __builtin_amdgcn_readlane(__builtin_bit_cast(int, gs), g2 * 8)); cnt += (sg > gs || (sg == gs && g2 < grp)) ? 1 : 0; }
        const bool sel = cnt < 4;
        unsigned k0 = sel ? ((fkey(v0) & 0xFFFFFF00u) | (unsigned)(255 - 4 * lane)) : 0u;
        unsigned k1 = sel ? ((fkey(v1) & 0xFFFFFF00u) | (unsigned)(254 - 4 * lane)) : 0u;
        unsigned k2 = sel ? ((fkey(v2) & 0xFFFFFF00u) | (unsigned)(253 - 4 * lane)) : 0u;
        unsigned k3 = sel ? ((fkey(v3) & 0xFFFFFF00u) | (unsigned)(252 - 4 * lane)) : 0u;
        int myidx = 0; float mys = 0.f, ssum = 0.f;
#pragma unroll
        for (int k = 0; k < 8; ++k) {
            const unsigned best = wave_umax(umax_(umax_(k0, k1), umax_(k2, k3)));
            const int bi = 255 - (int)(best & 0xFFu);
            const int sub = bi & 3, own = bi >> 2;
            const float ssel = sub == 0 ? s0 : (sub == 1 ? s1 : (sub == 2 ? s2 : s3));
            const float sc = __builtin_bit_cast(float, __builtin_amdgcn_readlane(__builtin_bit_cast(int, ssel), own));
            if (own == lane) { if (sub == 0) k0 = 0u; else if (sub == 1) k1 = 0u; else if (sub == 2) k2 = 0u; else k3 = 0u; }
            ssum += sc;
            if (lane == k) { myidx = bi; mys = sc; }
        }
        if (lane < 8) { IDX[(size_t)row * 8 + lane] = myidx; WTS[(size_t)row * 8 + lane] = mys / ssum * 2.5f; __hip_atomic_fetch_add(&hist[myidx], 1, __ATOMIC_RELAXED, __HIP_MEMORY_SCOPE_WORKGROUP); }
    }
    __syncthreads();
    if (F.tid < 256) HIST[F.bid * 256 + F.tid] = hist[F.tid];
}
__device__ __forceinline__ void phase_slots(const Frame& F0, int l) {
    const Frame F = refresh(F0);
    const GAS int* HIST = (const GAS int*)(F.ws + WS_HIST); const GAS int* IDX = (const GAS int*)(F.ws + WS_IDX);
    GAS int* POS = (GAS int*)(F.ws + WS_POS); GAS int* STOK = (GAS int*)(F.ws + WS_STOK);
    GAS i32x4* MT = (GAS i32x4*)(F.ws + WS_MT); GAS int* NMT = (GAS int*)(F.ws + WS_MT + 1536 * 16);
    LAS int* tot = (LAS int*)F.lds; LAS int* bef = tot + 256; LAS int* pst = bef + 256; LAS int* cur = pst + 256;
    __syncthreads();
    {
        LAS int* part = cur + 256;
        const int e4 = F.lane * 4, g0 = F.wave * 32;
        i32x4 t = (i32x4){0, 0, 0, 0}, bf = (i32x4){0, 0, 0, 0};
#pragma unroll
        for (int b = 0; b < 2; ++b) { i32x4 hv[16];
#pragma unroll
            for (int q = 0; q < 16; ++q) { const int g = g0 + b * 16 + q; hv[q] = (g < F.G) ? *(const GAS i32x4*)(HIST + (size_t)g * 256 + e4) : (i32x4){0, 0, 0, 0}; }
#pragma unroll
            for (int q = 0; q < 16; ++q) { const int g = g0 + b * 16 + q; t += hv[q]; if (g < F.bid) bf += hv[q]; } }
        *(LAS i32x4*)(part + F.wave * 256 + e4) = t; *(LAS i32x4*)(part + 2048 + F.wave * 256 + e4) = bf;
        __syncthreads();
        if (F.tid < 256) { int a = 0, b2 = 0;
#pragma unroll
            for (int w = 0; w < 8; ++w) { a += part[w * 256 + F.tid]; b2 += part[2048 + w * 256 + F.tid]; }
            tot[F.tid] = a; bef[F.tid] = b2; } }
    __syncthreads();
    if (F.tid < 64) {
        const int p0 = (tot[4 * F.tid] + 255) & ~255, p1 = (tot[4 * F.tid + 1] + 255) & ~255, p2 = (tot[4 * F.tid + 2] + 255) & ~255, p3 = (tot[4 * F.tid + 3] + 255) & ~255;
        int s = p0 + p1 + p2 + p3, x = s;
#pragma unroll
        for (int o = 1; o < 64; o <<= 1) { const int y = __shfl_up(x, o); if (F.tid >= o) x += y; }
        const int ex = x - s;
        pst[4 * F.tid] = ex; pst[4 * F.tid + 1] = ex + p0; pst[4 * F.tid + 2] = ex + p0 + p1; pst[4 * F.tid + 3] = ex + p0 + p1 + p2;
    }
    __syncthreads();
    if (F.tid < 256) cur[F.tid] = pst[F.tid] + bef[F.tid];
    __syncthreads();
    const int rpw = rows_per_wg(F, l), row0 = row_lo(l) + F.bid * rpw;
    for (int p = F.tid; p < rpw * 8; p += 512) {
        const int row = row0 + (p >> 3);
        if (row < NTOK) { const int e = IDX[(size_t)row * 8 + (p & 7)]; const int slot = __hip_atomic_fetch_add(&cur[e], 1, __ATOMIC_RELAXED, __HIP_MEMORY_SCOPE_WORKGROUP); STOK[slot] = row; POS[(size_t)row * 8 + (p & 7)] = slot; }
    }
    if (F.bid == 0) {
        if (F.tid < 256) { const int e = F.tid, t = tot[e], ntile = (t + 255) >> 8, t0 = pst[e] >> 8;
            for (int jt = 0; jt < ntile; ++jt) { const int nv = t - jt * 256; MT[t0 + jt] = (i32x4){e, pst[e] + jt * 256, nv < 256 ? nv : 256, 0}; } }
        const int ntr = (pst[255] + ((tot[255] + 255) & ~255)) >> 8;
        const int nsh = (NTOK - row_lo(l)) / 256;
        for (int jt = F.tid; jt < nsh; jt += 512) MT[ntr + jt] = (i32x4){NEXP, SH_BASE + row_lo(l) + jt * 256, 256, 0};
        if (F.tid == 0) *NMT = ntr + nsh;
    }
}
__device__ __forceinline__ void phase_ln2(const Frame& F0, const Args& A, int l) {
    const Frame F = refresh(F0);
    const GAS float* MODL = (const GAS float*)(F.ws + WS_MOD) + (size_t)l * 5 * 6144;
    const GAS float* MODN = (const GAS float*)(F.ws + WS_MOD) + (size_t)1 * 5 * 6144;
    const GAS unsigned char* Y = (const GAS unsigned char*)(F.ws + WS_Y);
    const GAS bf16_t* X1 = (const GAS bf16_t*)(F.ws + WS_X1);
    const GAS int* POS = (const GAS int*)(F.ws + WS_POS); const GAS float* WTS = (const GAS float*)(F.ws + WS_WTS);
    GAS bf16_t* XS = (GAS bf16_t*)(F.ws + WS_XS); GAS unsigned char* HX = (GAS unsigned char*)(F.ws + hxl(1));
    const int d0 = F.lane * 16;
    float g[16], be[16];
    ld16_f32(inp(F, I_LN2G) + (size_t)l * 1024 + d0, g); ld16_f32(inp(F, I_LN2B) + (size_t)l * 1024 + d0, be);
    const int stride = F.G * 8;
    for (int row0 = row_lo(l) + F.bid * 8 + F.wave; row0 < NTOK; row0 += 2 * stride) {
        const int rows[2] = {row0, row0 + stride < NTOK ? row0 + stride : row0};
        u32x4 yv[2][9]; float ww[2][9]; u32x4 xv[2][2];
#pragma unroll
        for (int r = 0; r < 2; ++r) {
            const int row = rows[r];
            const i32x4 p0 = *(const GAS i32x4*)(POS + (size_t)row * 8), p1 = *(const GAS i32x4*)(POS + (size_t)row * 8 + 4);
            const f32x4 w0 = *(const GAS f32x4*)(WTS + (size_t)row * 8), w1 = *(const GAS f32x4*)(WTS + (size_t)row * 8 + 4);
            const int sl[9] = {p0[0], p0[1], p0[2], p0[3], p1[0], p1[1], p1[2], p1[3], SH_BASE + row};
            ww[r][0] = w0[0]; ww[r][1] = w0[1]; ww[r][2] = w0[2]; ww[r][3] = w0[3]; ww[r][4] = w1[0]; ww[r][5] = w1[1]; ww[r][6] = w1[2]; ww[r][7] = w1[3]; ww[r][8] = 1.f;
#pragma unroll
            for (int k = 0; k < 9; ++k) yv[r][k] = __builtin_nontemporal_load((const GAS u32x4*)(Y + (size_t)sl[k] * 1024 + d0));
            xv[r][0] = *(const GAS u32x4*)(X1 + (size_t)row * 1024 + d0); xv[r][1] = *(const GAS u32x4*)(X1 + (size_t)row * 1024 + d0 + 8);
        }
#pragma unroll
        for (int r = 0; r < 2; ++r) {
            const int row = rows[r];
            if (r == 1 && row0 + stride >= NTOK) break;
            const int mr = mod_row(row);
            const GAS float* m = MODL + (size_t)mr * 6144;
            float f[16];
#pragma unroll
            for (int q = 0; q < 16; ++q) f[q] = 0.f;
#ifndef SKIP_MOE
#pragma unroll
            for (int k = 0; k < 9; ++k) { float t[16]; unpack16_fp8(yv[r][k], t);
#pragma unroll
                for (int q = 0; q < 16; ++q) f[q] += ww[r][k] * t[q]; }
#endif
            float x[16], gt[16], v[16];
            { float xa[8], xb[8]; unpack8(xv[r][0], xa); unpack8(xv[r][1], xb);
#pragma unroll
              for (int q = 0; q < 8; ++q) { x[q] = xa[q]; x[8 + q] = xb[q]; } }
            ld16_f32(m + 5120 + d0, gt);
            float s = 0.f;
#pragma unroll
            for (int q = 0; q < 16; ++q) { v[q] = ALPHA * x[q] + gt[q] * f[q]; s += v[q]; }
            const float mu = wave_sum(s) * (1.0f / 1024.0f);
            float qv = 0.f;
#pragma unroll
            for (int q = 0; q < 16; ++q) { const float dd = v[q] - mu; qv += dd * dd; }
            const float rstd = rsqrtf(wave_sum(qv) * (1.0f / 1024.0f) + LN_EPS);
            float o[16];
#pragma unroll
            for (int q = 0; q < 16; ++q) o[q] = (v[q] - mu) * rstd * g[q] + be[q];
            if (l == 0) {
                const GAS float* mn = MODN + (size_t)mr * 6144;
                float sc[16], sh[16], hx[16];
                ld16_f32(mn + 1024 + d0, sc); ld16_f32(mn + d0, sh);
#pragma unroll
                for (int q = 0; q < 16; ++q) hx[q] = o[q] * (1.f + sc[q]) + sh[q];
                st_row_bf16(F.lds + F.wave * 4096, F.lane, XS + (size_t)row * 1024, o);
                *(GAS u32x4*)(HX + (size_t)row * 1024 + d0) = pack16_fp8(hx);
            } else {
                st_row_f32(F.lds + F.wave * 4096, F.lane, ((GAS float*)inp(F, 24)) + (size_t)(row - NCTX) * 1024, o);
            }
        }
    }
}

__device__ __forceinline__ XcdBarrier mkbar(const Frame& F) {
    GAS unsigned char* w = (GAS unsigned char*)inp(F, 25);
    return XcdBarrier{(unsigned*)(w + WS_CTL), xb_xcc_id(), (volatile LAS unsigned*)(F.lds + L_BAR)};
}
constexpr int NPH = 14;
__global__ void __launch_bounds__(512, 2) mk_fwd(Args args) {
    extern __shared__ __attribute__((aligned(16))) unsigned char lds_raw[];
    Frame F;
    F.lds = (LAS unsigned char*)lds_raw; F.ws = args.ws;
    F.tid = threadIdx.x; F.lane = F.tid & 63; F.wave = __builtin_amdgcn_readfirstlane(F.tid >> 6); F.G = gridDim.x; F.bid = blockIdx.x;
    if (F.tid < 24) *(LAS unsigned long long*)(F.lds + L_PTR + F.tid * 8) = (unsigned long long)args.in[F.tid];
    if (F.tid == 24) *(LAS unsigned long long*)(F.lds + L_PTR + 24 * 8) = (unsigned long long)args.out;
    if (F.tid == 25) *(LAS unsigned long long*)(F.lds + L_PTR + 25 * 8) = (unsigned long long)args.ws;
    __syncthreads();
#if MK_N_LAUNCHES == 1
    constexpr int lo = 0, hi = DEPTH * NPH; constexpr bool multi = true;
#else
    const int lo = args.ph_lo, hi = args.ph_hi;
    const bool multi = (hi - lo) > 1;
#endif
    if (multi) {
        if (F.tid == 0) *(LAS u32x4*)(F.lds + L_BAR) = (u32x4){0u, 0u, 0u, 0u};
        __syncthreads();
        (void)xcd_barrier_post((unsigned*)(args.ws + WS_CTL), (volatile LAS unsigned*)(F.lds + L_BAR));
    }
#ifndef PH_MASK
#define PH_MASK 0x3fff
#endif
#define IN(k) (((PH_MASK >> ((k) - pb)) & 1) && lo <= (k) && (k) < hi)
#define MKBAR() mkbar(F)
#define SEAM(k) do { if (IN((k) + 1)) xcd_barrier(MKBAR()); } while (0)
#pragma unroll
    for (int l = 0; l < DEPTH; ++l) {
        const int pb = l * NPH;
#define REPEAT(n, k) for (int rep_ = 0; rep_ < (((REPMASK >> (k)) & 1) ? 2 : 1); ++rep_) { if (rep_) xcd_barrier(MKBAR());
        if (IN(pb + 0)) { if (l == 0) { REPEAT(REPA, 0) phase_weights(F, args, 0); phase_mod(F, args); } SEAM(pb + 0); } }
        if (IN(pb + 1)) { if (l == 0) { REPEAT(REPA, 1) phase_modulate0(F, args); } SEAM(pb + 1); } }
        if (IN(pb + 2)) {
            REPEAT(REPG, 2)
            { const Frame Fr = refresh(F); conv_run(Fr, l, 0, CONV_FRONT); conv_run(Fr, l, CONV_FRONT + CONV_TAIL, 8); __syncthreads(); }
            build_dense_tables(F, NTOK, INCP, 1024);
            pg8::DenseTabOrder S{F.lds, (const char*)(F.ws + hxl(l)), (const char*)(F.ws + wl(WS_WIN, l)), 1024, F.ws, F.bid, F.G, l, CONV_FRONT, CONV_TAIL};
            pg8::EpiBf16 E{(bf16_t*)(F.ws + WS_PX), INCP, INC};
            pg8::gemm_phase<pg8::EpiBf16, pg8::DenseTabOrder, true>(F.lds, 512, S, E); }
            SEAM(pb + 2);
        }
        if (IN(pb + 3)) { REPEAT(REPA, 3) phase_c1(F, args, l); } SEAM(pb + 3); }
        if (IN(pb + 4)) { REPEAT(REPA, 4) phase_c2(F); } SEAM(pb + 4); }
        if (IN(pb + 5)) { REPEAT(REPA, 5) phase_c3(F, args, l); } SEAM(pb + 5); }
        if (IN(pb + 6)) {
            REPEAT(REPG, 6)
            build_dense_tables(F, NTOK - row_lo(l), 1024, 1024, row_lo(l) / 256);
            pg8::DenseTabOrder S{F.lds, (const char*)(F.ws + WS_MIX), (const char*)(F.ws + wl(WS_WOUT, l)), 1024, F.ws, 0, 1, 0, 0, 0};
            pg8::EpiBf16 E{(bf16_t*)(F.ws + WS_YBF), 1024, 1024};
            pg8::gemm_phase<pg8::EpiBf16, pg8::DenseTabOrder, true>(F.lds, 512, S, E); }
            SEAM(pb + 6);
        }
        if (IN(pb + 7)) { REPEAT(REPA, 7) phase_ln1(F, args, l); } SEAM(pb + 7); }
        if (IN(pb + 8)) {
            REPEAT(REPG, 8)
            pg8::DenseOrder S; S.init(NTOK - row_lo(l), 256, 1024, (const char*)(F.ws + WS_HX2) + (size_t)row_lo(l) * 2048, (const char*)(F.ws + wl(WS_WR, l)), F.G, F.bid);
            pg8::EpiF32 E{(float*)(F.ws + WS_LOG) + (size_t)row_lo(l) * 256, 256};
            pg8::gemm_phase(F.lds, 1024, S, E); }
            SEAM(pb + 8);
        }
        if (IN(pb + 9)) { REPEAT(REPA, 9) phase_route(F, args, l); } SEAM(pb + 9); }
        if (IN(pb + 10)) { REPEAT(REPA, 10) phase_slots(F, l); } SEAM(pb + 10); }
        if (IN(pb + 11)) {
#define PH11_BODY { build_group_tables<2, true>(F); \
            pg8::Group1Order S{F.lds, (const char*)(F.ws + WS_HX2Q), (const char*)(F.ws + WS_BT1)}; \
            pg8::EpiSwiGLU E{(unsigned char*)(F.ws + WS_H)}; \
            pg8::gemm_phase<pg8::EpiSwiGLU, pg8::Group1Order, true>(F.lds, 512, S, E); }
            PH11_BODY
#if (REPMASK >> 11) & 1
            xcd_barrier(MKBAR()); PH11_BODY
#endif
            SEAM(pb + 11);
        }
        if (IN(pb + 12)) {
#define PH12_BODY { build_group_tables<4, false>(F); \
            pg8::Group2Order S{F.lds, (const char*)(F.ws + WS_H), (const char*)(F.ws + WS_BT2)}; \
            pg8::EpiY E{(unsigned char*)(F.ws + WS_Y)}; \
            pg8::gemm_phase<pg8::EpiY, pg8::Group2Order, true>(F.lds, 128, S, E); }
            PH12_BODY
#if (REPMASK >> 12) & 1
            xcd_barrier(MKBAR()); PH12_BODY
#endif
            SEAM(pb + 12);
        }
        if (IN(pb + 13)) { REPEAT(REPA, 13) phase_ln2(F, args, l); if (l == 0) phase_weights(F, args, 1); } SEAM(pb + 13); }
    }
#undef REPEAT
#undef IN
#undef SEAM
}

extern "C" void kernel_launch(void* const* d_in, const int* in_sizes, int n_in, void* d_out, int out_size, void* d_ws, size_t ws_size, hipStream_t stream) {
    static int grid = 0;
    if (grid == 0) {
        if (n_in != 24 || in_sizes[0] != NLAT * D || out_size != NLAT * D || ws_size < WS_END) {
            fprintf(stderr, "kernel_launch: unexpected problem (n_in %d, in0 %d, out %d, ws %zu, need %zu); nothing launched\n", n_in, n_in > 0 ? in_sizes[0] : -1, out_size, ws_size, (size_t)WS_END);
            grid = -1; return; }
        int dev = 0, cus = 0, per_cu = 0;
        if (hipGetDevice(&dev) != hipSuccess || hipDeviceGetAttribute(&cus, hipDeviceAttributeMultiprocessorCount, dev) != hipSuccess) { fprintf(stderr, "kernel_launch: device query failed\n"); grid = -1; return; }
        if (hipFuncSetAttribute((const void*)mk_fwd, hipFuncAttributeMaxDynamicSharedMemorySize, LDS_BYTES) != hipSuccess) { fprintf(stderr, "kernel_launch: hipFuncSetAttribute failed\n"); grid = -1; return; }
        if (hipOccupancyMaxActiveBlocksPerMultiprocessor(&per_cu, (const void*)mk_fwd, 512, LDS_BYTES) != hipSuccess || per_cu < 1)
            fprintf(stderr, "kernel_launch: note: occupancy query reports %d workgroups per CU\n", per_cu);
        (void)hipGetLastError();
        grid = cus;
        if (grid != 256) fprintf(stderr, "kernel_launch: note: %d CUs (built for 256)\n", grid);
        if (grid > 256) grid = 256;
    }
    if (grid < 0) return;
    if (hipMemsetAsync((char*)d_ws + WS_CTL, 0, 65536, stream) != hipSuccess) { fprintf(stderr, "kernel_launch: memset failed\n"); return; }
    Args a{};
    for (int i = 0; i < 24; ++i) a.in[i] = (const GAS float*)d_in[i];
    a.out = (GAS float*)d_out; a.ws = (GAS unsigned char*)d_ws;
#if MK_N_LAUNCHES == 1
    a.ph_lo = 0; a.ph_hi = DEPTH * NPH;
    hipLaunchKernelGGL(mk_fwd, dim3(grid), dim3(512), LDS_BYTES, stream, a);
#else
    for (int p = 0; p < DEPTH * NPH; ++p) {
        if (p == NPH + 1) continue;
        a.ph_lo = p; a.ph_hi = p + 1;
        hipLaunchKernelGGL(mk_fwd, dim3(grid), dim3(512), LDS_BYTES, stream, a);
    }
#endif
    const hipError_t le = hipPeekAtLastError();
    if (le != hipSuccess) fprintf(stderr, "kernel_launch: launch failed: %s\n", hipGetErrorName(le));
}
```
